# Optimizing an MI355X kernel written in HIP

```python
import math
import jax, jax.numpy as jnp
from jax import lax
import numpy as np

D_MODEL = 1024
BATCH = 8
SEQ = 4096
DEPTH = 2

CHUNK = 64
NORM_EPS = 1e-6
S5_WIDTH = D_MODEL // 2
S5_GROUP = 16
S5_GROUPS = S5_WIDTH // S5_GROUP
S5_STATE = 64
CONV_WIDTH = D_MODEL // 2
CONV_KERNEL = 31
EVEN_IN = 2 * S5_WIDTH + 3 * CONV_WIDTH
N_HEADS = 16
HEAD_DIM = D_MODEL // N_HEADS
N_KV_HEADS = 4
Q_PER_KV = N_HEADS // N_KV_HEADS
ATT_WIDTH = N_HEADS * HEAD_DIM
KV_WIDTH = N_KV_HEADS * HEAD_DIM
IDX_HEADS = 8
IDX_DIM = 64
TOPK_MAX = 256
ODD_IN = 2 * ATT_WIDTH + 2 * KV_WIDTH + IDX_HEADS * IDX_DIM + IDX_DIM + IDX_HEADS
ROPE_THETA = 500000.0
ROT_DIM = HEAD_DIM // 4
N_EVEN = (DEPTH + 1) // 2
N_ODD = DEPTH // 2

kernel_name = "chunk_causal_s5_conformer_dsa_hybrid"


def rms_norm(x, g):
    xf = x.astype(jnp.float32)
    y = xf * lax.rsqrt(jnp.mean(xf * xf, axis=-1, keepdims=True) + NORM_EPS)
    return (y * g.astype(jnp.float32)).astype(x.dtype)


def rope_tables(length):
    pos = jnp.arange(length, dtype=jnp.float32)
    inv = ROPE_THETA ** (-jnp.arange(0, ROT_DIM, 2, dtype=jnp.float32) / ROT_DIM)
    ang = pos[:, None] * inv[None, :]
    return jnp.cos(ang), jnp.sin(ang)


def partial_rope(x, cos, sin):
    half = ROT_DIM // 2
    x1, x2, rest = x[..., :half], x[..., half:ROT_DIM], x[..., ROT_DIM:]
    shape = (1, cos.shape[0]) + (1,) * (x.ndim - 3) + (half,)
    c = cos.reshape(shape).astype(x.dtype)
    s = sin.reshape(shape).astype(x.dtype)
    return jnp.concatenate([x1 * c - x2 * s, x1 * s + x2 * c, rest], axis=-1)


def s5_mixer(u, lam_re, lam_im, log_step, b_re, b_im, c_re, c_im, d_skip, w_glu, b_glu):
    f32 = jnp.float32
    bsz, length, _ = u.shape
    uf = u.astype(f32).reshape(bsz, length, S5_GROUPS, S5_GROUP)
    lr = jnp.minimum(lam_re.astype(f32), -1e-4)
    li = lam_im.astype(f32)
    dt = jnp.exp(log_step.astype(f32))[:, None]
    mag = jnp.exp(lr * dt)
    ab_re = mag * jnp.cos(li * dt)
    ab_im = mag * jnp.sin(li * dt)
    den = lr * lr + li * li
    nr = ab_re - 1.0
    ni = ab_im
    k_re = (nr * lr + ni * li) / den
    k_im = (ni * lr - nr * li) / den
    br = b_re.astype(f32)
    bi = b_im.astype(f32)
    bb_re = k_re[..., None] * br - k_im[..., None] * bi
    bb_im = k_re[..., None] * bi + k_im[..., None] * br
    x_re = jnp.einsum("blgc,gnc->blgn", uf, bb_re)
    x_im = jnp.einsum("blgc,gnc->blgn", uf, bb_im)
    a_re = jnp.broadcast_to(ab_re[None, None], (1, length, S5_GROUPS, S5_STATE))
    a_im = jnp.broadcast_to(ab_im[None, None], (1, length, S5_GROUPS, S5_STATE))

    def combine(e1, e2):
        a1r, a1i, b1r, b1i = e1
        a2r, a2i, b2r, b2i = e2
        return (a2r * a1r - a2i * a1i,
                a2r * a1i + a2i * a1r,
                a2r * b1r - a2i * b1i + b2r,
                a2r * b1i + a2i * b1r + b2i)

    _, _, s_re, s_im = lax.associative_scan(combine, (a_re, a_im, x_re, x_im), axis=1)
    y = (jnp.einsum("blgn,gcn->blgc", s_re, c_re.astype(f32))
         - jnp.einsum("blgn,gcn->blgc", s_im, c_im.astype(f32)))
    y = y + uf * d_skip.astype(f32).reshape(S5_GROUPS, S5_GROUP)
    g = jax.nn.gelu(y.reshape(bsz, length, S5_WIDTH))
    out = g * jax.nn.sigmoid(g @ w_glu.astype(f32) + b_glu.astype(f32))
    return out.astype(u.dtype)


def conformer_conv(v, g, conv_w, conv_b, ln_g, ln_b):
    h = v * jax.nn.sigmoid(g)
    h = lax.conv_general_dilated(
        h, conv_w[:, None, :], window_strides=(1,), padding=[(CONV_KERNEL - 1, 0)],
        dimension_numbers=("NWC", "WIO", "NWC"), feature_group_count=CONV_WIDTH) + conv_b
    hf = h.astype(jnp.float32)
    mu = jnp.mean(hf, axis=-1, keepdims=True)
    var = jnp.mean(jnp.square(hf - mu), axis=-1, keepdims=True)
    hf = (hf - mu) * lax.rsqrt(var + NORM_EPS) * ln_g.astype(jnp.float32) + ln_b.astype(jnp.float32)
    return jax.nn.silu(hf).astype(v.dtype)


def even_layer(h, w_in, lam_re, lam_im, log_step, b_re, b_im, c_re, c_im, d_skip, w_glu, b_glu,
               conv_w, conv_b, ln_g, ln_b, w_out):
    proj = h @ w_in
    u_a = proj[..., :S5_WIDTH]
    z_a = proj[..., S5_WIDTH:2 * S5_WIDTH]
    o = 2 * S5_WIDTH
    v_b = proj[..., o:o + CONV_WIDTH]
    g_b = proj[..., o + CONV_WIDTH:o + 2 * CONV_WIDTH]
    z_b = proj[..., o + 2 * CONV_WIDTH:]
    y_a = s5_mixer(u_a, lam_re, lam_im, log_step, b_re, b_im, c_re, c_im, d_skip, w_glu, b_glu)
    y_b = conformer_conv(v_b, g_b, conv_w, conv_b, ln_g, ln_b)
    y = jnp.concatenate([y_a * jax.nn.silu(z_a), y_b * jax.nn.silu(z_b)], axis=-1)
    return y @ w_out


def odd_layer(h, w_in, w_out):
    bsz, length, _ = h.shape
    f32 = jnp.float32
    proj = h @ w_in
    sizes = [ATT_WIDTH, ATT_WIDTH, KV_WIDTH, KV_WIDTH, IDX_HEADS * IDX_DIM, IDX_DIM]
    offs = np.cumsum([0] + sizes).tolist()
    q, z, k, v, qi, ki = [proj[..., offs[i]:offs[i + 1]] for i in range(len(sizes))]
    wi = proj[..., offs[-1]:]
    cos, sin = rope_tables(length)
    q = partial_rope(q.reshape(bsz, length, N_KV_HEADS, Q_PER_KV, HEAD_DIM), cos, sin)
    k = partial_rope(k.reshape(bsz, length, N_KV_HEADS, HEAD_DIM), cos, sin)
    v = v.reshape(bsz, length, N_KV_HEADS, HEAD_DIM)
    qi = partial_rope(qi.reshape(bsz, length, IDX_HEADS, IDX_DIM), cos, sin).astype(f32)
    ki = partial_rope(ki, cos, sin).astype(f32)
    wi = wi.astype(f32) * (IDX_HEADS ** -0.5) * (IDX_DIM ** -0.5)
    n_blk = length // CHUNK
    ksel = min(TOPK_MAX, length // 4)
    key_chunk = jnp.arange(length) // CHUNK
    scale = HEAD_DIM ** -0.5

    def block(c):
        s0 = c * CHUNK
        qb = lax.dynamic_slice_in_dim(q, s0, CHUNK, axis=1)
        qib = lax.dynamic_slice_in_dim(qi, s0, CHUNK, axis=1)
        wib = lax.dynamic_slice_in_dim(wi, s0, CHUNK, axis=1)
        isc = jax.nn.relu(jnp.einsum("bqhd,bsd->bqhs", qib, ki))
        score = jnp.einsum("bqh,bqhs->bqs", wib, isc)
        score = jnp.where((key_chunk <= c)[None, None, :], score, -jnp.inf)
        _, idx = lax.top_k(score, ksel)
        valid = (idx // CHUNK) <= c
        kg = jax.vmap(lambda kk, ii: kk[ii])(k, idx)
        vg = jax.vmap(lambda vv, ii: vv[ii])(v, idx)
        logits = jnp.einsum("bqhgd,bqkhd->bqhgk", qb.astype(f32), kg.astype(f32)) * scale
        logits = jnp.where(valid[:, :, None, None, :], logits, -jnp.inf)
        p = jax.nn.softmax(logits, axis=-1).astype(v.dtype)
        ob = jnp.einsum("bqhgk,bqkhd->bqhgd", p, vg)
        return ob.reshape(bsz, CHUNK, ATT_WIDTH)

    out = lax.map(block, jnp.arange(n_blk))
    out = out.transpose(1, 0, 2, 3).reshape(bsz, length, ATT_WIDTH)
    return (out * jax.nn.silu(z)) @ w_out


def setup_inputs(seed: int = 0) -> dict:
    key = jax.random.key(seed)
    ks = jax.random.split(key, 24)
    f32 = jnp.float32
    nrm = lambda k, shape, s: jax.random.normal(k, shape, f32) * s
    G, N, C = S5_GROUPS, S5_STATE, S5_GROUP
    n_idx = jnp.arange(N, dtype=f32)
    return {
        "x": nrm(ks[0], (BATCH, SEQ, D_MODEL), 1.0),
        "norm_g": 1.0 + nrm(ks[1], (DEPTH, D_MODEL), 0.02),
        "e_w_in": nrm(ks[2], (N_EVEN, D_MODEL, EVEN_IN), D_MODEL ** -0.5),
        "e_lam_re": -0.5 + nrm(ks[3], (N_EVEN, G, N), 0.01),
        "e_lam_im": jnp.pi * n_idx[None, None, :] + nrm(ks[4], (N_EVEN, G, N), 0.01),
        "e_log_step": jax.random.uniform(ks[5], (N_EVEN, G), f32, math.log(1e-3), math.log(1e-1)),
        "e_b_re": nrm(ks[6], (N_EVEN, G, N, C), (2 * C) ** -0.5),
        "e_b_im": nrm(ks[7], (N_EVEN, G, N, C), (2 * C) ** -0.5),
        "e_c_re": nrm(ks[8], (N_EVEN, G, C, N), N ** -0.5),
        "e_c_im": nrm(ks[9], (N_EVEN, G, C, N), N ** -0.5),
        "e_d_skip": nrm(ks[10], (N_EVEN, S5_WIDTH), 1.0),
        "e_w_glu": nrm(ks[11], (N_EVEN, S5_WIDTH, S5_WIDTH), S5_WIDTH ** -0.5),
        "e_b_glu": nrm(ks[12], (N_EVEN, S5_WIDTH), 0.01),
        "e_conv_w": nrm(ks[13], (N_EVEN, CONV_KERNEL, CONV_WIDTH), CONV_KERNEL ** -0.5),
        "e_conv_b": nrm(ks[14], (N_EVEN, CONV_WIDTH), 0.01),
        "e_ln_g": 1.0 + nrm(ks[15], (N_EVEN, CONV_WIDTH), 0.02),
        "e_ln_b": nrm(ks[16], (N_EVEN, CONV_WIDTH), 0.01),
        "e_w_out": nrm(ks[17], (N_EVEN, S5_WIDTH + CONV_WIDTH, D_MODEL), (S5_WIDTH + CONV_WIDTH) ** -0.5),
        "o_w_in": nrm(ks[18], (N_ODD, D_MODEL, ODD_IN), D_MODEL ** -0.5),
        "o_w_out": nrm(ks[19], (N_ODD, ATT_WIDTH, D_MODEL), ATT_WIDTH ** -0.5),
        "final_g": 1.0 + nrm(ks[20], (D_MODEL,), 0.02),
    }


def reference(x, norm_g, e_w_in, e_lam_re, e_lam_im, e_log_step, e_b_re, e_b_im, e_c_re, e_c_im,
              e_d_skip, e_w_glu, e_b_glu, e_conv_w, e_conv_b, e_ln_g, e_ln_b, e_w_out,
              o_w_in, o_w_out, final_g):
    h = x
    for layer in range(DEPTH):
        hn = rms_norm(h, norm_g[layer])
        if layer % 2 == 0:
            j = layer // 2
            y = even_layer(hn, e_w_in[j], e_lam_re[j], e_lam_im[j], e_log_step[j], e_b_re[j], e_b_im[j],
                           e_c_re[j], e_c_im[j], e_d_skip[j], e_w_glu[j], e_b_glu[j], e_conv_w[j],
                           e_conv_b[j], e_ln_g[j], e_ln_b[j], e_w_out[j])
        else:
            j = layer // 2
            y = odd_layer(hn, o_w_in[j], o_w_out[j])
        h = h + y.astype(h.dtype)
    return rms_norm(h, final_g)
```

```cpp
#include <hip/hip_runtime.h>
#include <hip/hip_cooperative_groups.h>
#include <cstdio>
#include <cstdint>
namespace cg = cooperative_groups;

#define LAS __attribute__((address_space(3)))
typedef _Float16 h16;
typedef _Float16 f16x8 __attribute__((ext_vector_type(8)));
typedef _Float16 f16x4 __attribute__((ext_vector_type(4)));
typedef _Float16 f16x2 __attribute__((ext_vector_type(2)));
typedef float f32x2 __attribute__((ext_vector_type(2)));
typedef float f32x4 __attribute__((ext_vector_type(4)));
typedef float f32x16 __attribute__((ext_vector_type(16)));
typedef unsigned u32x4 __attribute__((ext_vector_type(4)));
typedef short v4i16_t __attribute__((ext_vector_type(4)));

#ifndef PH_EN
#define PH_EN 0xFFF
#endif
#ifndef ONE_LAUNCH
#define ONE_LAUNCH 0
#endif

constexpr int NB = 8, SEQ = 4096, DM = 1024, MTOK = NB * SEQ;
constexpr int NE_IN = 2560, NO_IN = 3144, NO_PAD = 3328;
constexpr float NORM_EPS = 1e-6f;
constexpr int NTHREADS = 512;
constexpr int LDS_BYTES = 153600;
constexpr int NPHASE = 12;

constexpr size_t MiB = 1u << 20;
constexpr size_t WS_RSS1 = 0, WS_RSS2 = 128 * 1024, CTL_ZERO_BYTES = 256 * 1024;
constexpr size_t WS_ROPE = 1 * MiB;
constexpr size_t WS_ABT = 1 * MiB + 512 * 1024;
constexpr size_t WS_WE_IN = 2 * MiB;
constexpr size_t WS_WGLU = 7 * MiB;
constexpr size_t WS_WE_OUT = 8 * MiB;
constexpr size_t WS_WO_IN = 10 * MiB;
constexpr size_t WS_WO_OUT = 17 * MiB;
constexpr size_t WS_MY = 19 * MiB;
constexpr size_t WS_MS = 25 * MiB;
constexpr size_t WS_XN = 32 * MiB;
constexpr size_t WS_UA = 96 * MiB;
constexpr size_t WS_SEND = 144 * MiB;
constexpr size_t WS_ZA = 176 * MiB;
constexpr size_t WS_HB = 208 * MiB;
constexpr size_t WS_ZB = 240 * MiB;
constexpr size_t WS_GG = 272 * MiB;
constexpr size_t WS_YCAT = 304 * MiB;
constexpr size_t WS_Q = 96 * MiB;
constexpr size_t WS_ZS = 160 * MiB;
constexpr size_t WS_KB = 224 * MiB;
constexpr size_t WS_VB = 240 * MiB;
constexpr size_t WS_QI = 256 * MiB;
constexpr size_t WS_KI = 288 * MiB;
constexpr size_t WS_WI = 292 * MiB;
constexpr size_t WS_MASK = 296 * MiB;
constexpr size_t WS_AO = 312 * MiB;
constexpr size_t WS_END = 376 * MiB;

struct Args {
    const float* x; const float* norm_g; const float* e_w_in; const float* e_lam_re; const float* e_lam_im; const float* e_log_step;
    const float* e_b_re; const float* e_b_im; const float* e_c_re; const float* e_c_im; const float* e_d_skip; const float* e_w_glu; const float* e_b_glu;
    const float* e_conv_w; const float* e_conv_b; const float* e_ln_g; const float* e_ln_b; const float* e_w_out; const float* o_w_in; const float* o_w_out; const float* final_g;
    float* out; unsigned char* ws; int ph_lo, ph_hi;
};

__device__ __forceinline__ float wave_sum(float v) {
#pragma unroll
    for (int o = 1; o < 64; o <<= 1) v += __shfl_xor(v, o);
    return v;
}
__device__ __forceinline__ float sigmoidf_(float x) { return 1.0f / (1.0f + __expf(-x)); }
__device__ __forceinline__ float siluf_(float x) { return x / (1.0f + __expf(-x)); }
__device__ __forceinline__ float gelu_tanh(float x) {
    const float u = 0.7978845608028654f * (x + 0.044715f * x * x * x);
    const float e = __expf(2.0f * u);
    const float t = 1.0f - 2.0f / (e + 1.0f);
    return 0.5f * x * (1.0f + t);
}
__device__ __forceinline__ f16x8 cvt8(const f32x4 a, const f32x4 b) {
    f16x8 o; o[0] = (h16)a[0]; o[1] = (h16)a[1]; o[2] = (h16)a[2]; o[3] = (h16)a[3]; o[4] = (h16)b[0]; o[5] = (h16)b[1]; o[6] = (h16)b[2]; o[7] = (h16)b[3]; return o;
}

constexpr int BM = 256, BK = 64, HALF = 128, HTB = HALF * BK * 2, STAGE_BYTES = 8 * HTB;
__device__ __forceinline__ int lds_byte(int r, int c) { const int st = (r >> 4) * 2 + (c >> 5), rr = r & 15, cc = c & 31, ob = rr * 64 + cc * 2; return st * 1024 + (ob ^ (((ob >> 9) & 1) << 5)); }
__device__ __forceinline__ void stage_rc(int b, int& R, int& C) { const int st = b / 1024, sb = b % 1024, swz = sb ^ (((sb >> 9) & 1) << 5); R = (st >> 1) * 16 + swz / 64; C = (st & 1) * 32 + (swz % 64) / 2; }
__device__ __forceinline__ int perm32(int rho) { const int n = rho >> 4, i = rho & 15; return 8 * (i >> 2) + 4 * n + (i & 3); }

struct Unit { int pm, pn, grp; };
struct GemmP { const char* A; const char* Bt; int lda, ldb, K; long gsA, gsB; int nM, nN, ngrp; };

__device__ __forceinline__ bool unit_next(const GemmP& g, int i, int G, int c, Unit& u) {
    const long Lx = (long)i * G + c;
    const bool grouped = g.ngrp > 0;
    const int nwg = grouped ? g.nM * g.ngrp : g.nM * g.nN;
    const bool ok = Lx < (long)nwg;
    const int L0 = ok ? (int)Lx : 0;
    const int gpm = L0 % g.nM, ggrp = L0 / g.nM;
    int wgid = L0; { const int q = nwg / 8, r = nwg % 8, xcd = wgid % 8, off = wgid / 8; wgid = (xcd < r ? xcd * (q + 1) : r * (q + 1) + (xcd - r) * q) + off; }
    const int nig = 8 * g.nN, gid = wgid / nig, fm = gid * 8, gsz = (g.nM - fm) < 8 ? (g.nM - fm) : 8;
    const int dpm = fm + ((wgid % nig) % gsz), dpn = (wgid % nig) / gsz;
    Unit r; r.pm = grouped ? gpm : dpm; r.pn = grouped ? 0 : dpn; r.grp = grouped ? ggrp : 0;
    u = r; return ok;
}

enum EpiMode { E_EVEN_IN = 0, E_SEND = 1, E_Y = 2, E_GLU = 3, E_OUT_EVEN = 4, E_ODD_IN = 5, E_OUT_ODD = 6 };

__device__ __forceinline__ void epilogue(const int mode, const Args& a, const f32x4 (&acc)[2][2][4][2], const Unit& u, int wr, int wc, int fr, int fq) {
    asm volatile("" : "+v"(fr), "+v"(fq));
    unsigned char* ws = a.ws;
    const int colw = 32 * wc + 8 * fq;
    if (mode == E_EVEN_IN) {
        const int pn = u.pn;
        if (pn >= 4 && pn < 8) {
            h16* HB = (h16*)(ws + WS_HB);
#pragma unroll
            for (int ai = 0; ai < 2; ++ai)
#pragma unroll
                for (int m = 0; m < 4; ++m) {
                    const int row = u.pm * BM + ai * HALF + wr * 64 + m * 16 + fr;
                    f32x4 o0, o1;
#pragma unroll
                    for (int j = 0; j < 4; ++j) { o0[j] = acc[ai][0][m][0][j] * sigmoidf_(acc[ai][1][m][0][j]); o1[j] = acc[ai][0][m][1][j] * sigmoidf_(acc[ai][1][m][1][j]); }
                    *(f16x8*)(HB + (size_t)row * 512 + (pn - 4) * 128 + colw) = cvt8(o0, o1);
                }
        } else {
#pragma unroll
            for (int ai = 0; ai < 2; ++ai)
#pragma unroll
                for (int m = 0; m < 4; ++m) {
                    const int row = u.pm * BM + ai * HALF + wr * 64 + m * 16 + fr;
#pragma unroll
                    for (int bj = 0; bj < 2; ++bj) {
                        const int col = pn * BM + bj * HALF + colw;
                        f32x4 v0 = acc[ai][bj][m][0], v1 = acc[ai][bj][m][1];
                        if (pn < 2) {
                            const int g = col >> 4;
                            h16* p = (h16*)(ws + WS_UA) + (size_t)g * (2048 * 384) + (size_t)(row >> 4) * 384 + (row & 15) * 16 + (col & 15);
                            *(f16x8*)p = cvt8(v0, v1);
                        } else {
#pragma unroll
                            for (int j = 0; j < 4; ++j) { v0[j] = siluf_(v0[j]); v1[j] = siluf_(v1[j]); }
                            if (pn < 4) *(f16x8*)((h16*)(ws + WS_ZA) + (size_t)row * 512 + (col - 512)) = cvt8(v0, v1);
                            else        *(f16x8*)((h16*)(ws + WS_ZB) + (size_t)row * 512 + (col - 2048)) = cvt8(v0, v1);
                        }
                    }
                }
        }
    } else if (mode == E_SEND) {
        float* SE = (float*)(ws + WS_SEND) + (size_t)u.grp * (2048 * 128);
#pragma unroll
        for (int ai = 0; ai < 2; ++ai)
#pragma unroll
            for (int m = 0; m < 4; ++m) {
                const int row = u.pm * BM + ai * HALF + wr * 64 + m * 16 + fr;
                float* p = SE + (size_t)row * 128 + colw;
                *(f32x4*)p = acc[ai][0][m][0]; *(f32x4*)(p + 4) = acc[ai][0][m][1];
            }
    } else if (mode == E_Y) {
        const h16* UA = (const h16*)(ws + WS_UA) + (size_t)u.grp * (2048 * 384);
        h16* GG = (h16*)(ws + WS_GG);
#pragma unroll
        for (int bj = 0; bj < 2; ++bj) {
            const int col = bj * HALF + colw, t = col >> 4, c0 = col & 15;
            const f32x4 d0 = *(const f32x4*)(a.e_d_skip + u.grp * 16 + c0), d1 = *(const f32x4*)(a.e_d_skip + u.grp * 16 + c0 + 4);
#pragma unroll
            for (int ai = 0; ai < 2; ++ai)
#pragma unroll
                for (int m = 0; m < 4; ++m) {
                    const int row = u.pm * BM + ai * HALF + wr * 64 + m * 16 + fr;
                    const f16x8 uu = *(const f16x8*)(UA + (size_t)row * 384 + col);
                    f32x4 o0, o1;
#pragma unroll
                    for (int j = 0; j < 4; ++j) { o0[j] = gelu_tanh(acc[ai][bj][m][0][j] + (float)uu[j] * d0[j]); o1[j] = gelu_tanh(acc[ai][bj][m][1][j] + (float)uu[4 + j] * d1[j]); }
                    *(f16x8*)(GG + ((size_t)row * 16 + t) * 512 + u.grp * 16 + c0) = cvt8(o0, o1);
                }
        }
    } else if (mode == E_GLU) {
        const h16* GG = (const h16*)(ws + WS_GG); const h16* ZA = (const h16*)(ws + WS_ZA); h16* YC = (h16*)(ws + WS_YCAT);
#pragma unroll
        for (int bj = 0; bj < 2; ++bj) {
            const int col = u.pn * BM + bj * HALF + colw;
            const f32x4 b0 = *(const f32x4*)(a.e_b_glu + col), b1 = *(const f32x4*)(a.e_b_glu + col + 4);
#pragma unroll
            for (int ai = 0; ai < 2; ++ai)
#pragma unroll
                for (int m = 0; m < 4; ++m) {
                    const int row = u.pm * BM + ai * HALF + wr * 64 + m * 16 + fr;
                    const f16x8 gg = *(const f16x8*)(GG + (size_t)row * 512 + col), za = *(const f16x8*)(ZA + (size_t)row * 512 + col);
                    f32x4 o0, o1;
#pragma unroll
                    for (int j = 0; j < 4; ++j) { o0[j] = (float)gg[j] * sigmoidf_(acc[ai][bj][m][0][j] + b0[j]) * (float)za[j]; o1[j] = (float)gg[4 + j] * sigmoidf_(acc[ai][bj][m][1][j] + b1[j]) * (float)za[4 + j]; }
                    *(f16x8*)(YC + (size_t)row * 1024 + col) = cvt8(o0, o1);
                }
        }
    } else if (mode == E_OUT_EVEN || mode == E_OUT_ODD) {
        const float* base = (mode == E_OUT_EVEN) ? a.x : a.out;
        float* rss = (float*)(ws + (mode == E_OUT_EVEN ? WS_RSS1 : WS_RSS2));
        h16* H1 = (h16*)(ws + WS_XN);
#pragma unroll
        for (int ai = 0; ai < 2; ++ai)
#pragma unroll
            for (int m = 0; m < 4; ++m) {
                const int row = u.pm * BM + ai * HALF + wr * 64 + m * 16 + fr;
                float ss = 0.f;
#pragma unroll
                for (int bj = 0; bj < 2; ++bj) {
                    const int col = u.pn * BM + bj * HALF + colw;
                    const size_t off = (size_t)row * 1024 + col;
                    const f32x4 x0 = *(const f32x4*)(base + off), x1 = *(const f32x4*)(base + off + 4);
                    const f32x4 h0 = x0 + acc[ai][bj][m][0], h1 = x1 + acc[ai][bj][m][1];
                    *(f32x4*)(a.out + off) = h0; *(f32x4*)(a.out + off + 4) = h1;
                    if (mode == E_OUT_EVEN) *(f16x8*)(H1 + off) = cvt8(h0, h1);
#pragma unroll
                    for (int j = 0; j < 4; ++j) ss += h0[j] * h0[j] + h1[j] * h1[j];
                }
                ss += __shfl_xor(ss, 16); ss += __shfl_xor(ss, 32);
                if (fq == 0) atomicAdd(rss + row, ss);
            }
    } else if (mode == E_ODD_IN) {
        const int pn = u.pn;
        const float* rss = (const float*)(ws + WS_RSS1);
        const float* ROPE = (const float*)(ws + WS_ROPE);
#pragma unroll
        for (int ai = 0; ai < 2; ++ai)
#pragma unroll
            for (int m = 0; m < 4; ++m) {
                const int row = u.pm * BM + ai * HALF + wr * 64 + m * 16 + fr;
                const float rs = 1.0f / sqrtf(rss[row] * (1.0f / 1024.0f) + NORM_EPS);
                const int pos = row & (SEQ - 1);
#pragma unroll
                for (int bj = 0; bj < 2; ++bj) {
                    const int col = pn * BM + bj * HALF + colw;
                    f32x4 v0 = acc[ai][bj][m][0] * rs, v1 = acc[ai][bj][m][1] * rs;
                    const bool ropeT = (pn < 4) || pn == 8 || pn == 10 || pn == 11 || (pn == 12 && col < 3072 + 64);
                    if (ropeT && (col & 63) < 16) {
                        const int i0 = (col & 63) >> 1;
                        const f32x4 cs0 = *(const f32x4*)(ROPE + pos * 16 + i0 * 2), cs1 = *(const f32x4*)(ROPE + pos * 16 + i0 * 2 + 4);
                        f32x4 r0, r1;
                        r0[0] = v0[0] * cs0[0] - v0[1] * cs0[1]; r0[1] = v0[0] * cs0[1] + v0[1] * cs0[0];
                        r0[2] = v0[2] * cs0[2] - v0[3] * cs0[3]; r0[3] = v0[2] * cs0[3] + v0[3] * cs0[2];
                        r1[0] = v1[0] * cs1[0] - v1[1] * cs1[1]; r1[1] = v1[0] * cs1[1] + v1[1] * cs1[0];
                        r1[2] = v1[2] * cs1[2] - v1[3] * cs1[3]; r1[3] = v1[2] * cs1[3] + v1[3] * cs1[2];
                        v0 = r0; v1 = r1;
                    }
                    if (pn < 4) *(f16x8*)((h16*)(ws + WS_Q) + (size_t)row * 1024 + col) = cvt8(v0, v1);
                    else if (pn < 8) {
#pragma unroll
                        for (int j = 0; j < 4; ++j) { v0[j] = siluf_(v0[j]); v1[j] = siluf_(v1[j]); }
                        *(f16x8*)((h16*)(ws + WS_ZS) + (size_t)row * 1024 + (col - 1024)) = cvt8(v0, v1);
                    } else if (pn == 8) *(f16x8*)((h16*)(ws + WS_KB) + (size_t)row * 256 + (col - 2048)) = cvt8(v0, v1);
                    else if (pn == 9) *(f16x8*)((h16*)(ws + WS_VB) + (size_t)row * 256 + (col - 2304)) = cvt8(v0, v1);
                    else if (pn < 12) *(f16x8*)((h16*)(ws + WS_QI) + (size_t)row * 512 + (col - 2560)) = cvt8(v0, v1);
                    else {
                        const int cl = col - 3072;
                        if (cl < 64) *(f16x8*)((h16*)(ws + WS_KI) + (size_t)row * 64 + cl) = cvt8(v0, v1);
                        else if (cl == 64) { float* w = (float*)(ws + WS_WI) + (size_t)row * 8; *(f32x4*)w = v0 * 0.04419417382415922f; *(f32x4*)(w + 4) = v1 * 0.04419417382415922f; }
                    }
                }
            }
    }
}

__device__ __forceinline__ void gemm_phase(LAS unsigned char* lds, const GemmP g, const int mode, const Args& a, const int G, const int c) {
    int tid = threadIdx.x; asm volatile("" : "+v"(tid));
    const int wid = __builtin_amdgcn_readfirstlane(tid >> 6), lane = tid & 63, wr = wid >> 2, wc = wid & 3, fr = lane & 15, fq = lane >> 4;
    const int nt = g.K / BK;
    unsigned voffA[2], voffB[2];
#pragma unroll
    for (int i = 0; i < 2; ++i) { int R, C; stage_rc(tid * 16 + i * 8192, R, C); const int Rb = (R & ~31) + perm32(R & 31);
        voffA[i] = (unsigned)(R * g.lda + C) * 2u; voffB[i] = (unsigned)(Rb * g.ldb + C) * 2u; }
    const size_t kstep = (size_t)(BK * 2);
    const size_t hstepA = (size_t)HALF * g.lda * 2, hstepB = (size_t)HALF * g.ldb * 2;
    const unsigned ldsw = (unsigned)wid * 1024u;
    const int aoff = lds_byte(wr * 64 + fr, fq * 8), boff = lds_byte(wc * 32 + fr, fq * 8);
#define PG8_SA(b, h) (((b) * 2 + (h)) * HTB)
#define PG8_SB(b, h) ((4 + (b) * 2 + (h)) * HTB)
#define PG8_STAGE(bufoff, gbase, voff) do { _Pragma("unroll") for (int _i = 0; _i < 2; ++_i) \
        __builtin_amdgcn_global_load_lds((const unsigned*)((const char*)(gbase) + (voff)[_i]), (LAS unsigned*)(lds + (bufoff) + ldsw + _i * 8192), 16, 0, 0); } while (0)
#define PG8_LDA(dst, b, h) do { _Pragma("unroll") for (int m = 0; m < 4; ++m) _Pragma("unroll") for (int k = 0; k < 2; ++k) dst[m][k] = *(const LAS f16x8*)(lds + PG8_SA(b, h) + aoff + m * 2048 + k * 1024); } while (0)
#define PG8_LDB(dst, b, h) do { _Pragma("unroll") for (int n = 0; n < 2; ++n) _Pragma("unroll") for (int k = 0; k < 2; ++k) dst[n][k] = *(const LAS f16x8*)(lds + PG8_SB(b, h) + boff + n * 2048 + k * 1024); } while (0)
#define PG8_MMA(ai, bj, At, Bt) do { __builtin_amdgcn_s_setprio(1); _Pragma("unroll") for (int m = 0; m < 4; ++m) _Pragma("unroll") for (int n = 0; n < 2; ++n) _Pragma("unroll") for (int k = 0; k < 2; ++k) \
        acc[ai][bj][m][n] = __builtin_amdgcn_mfma_f32_16x16x32_f16(Bt[n][k], At[m][k], acc[ai][bj][m][n], 0, 0, 0); __builtin_amdgcn_s_setprio(0); } while (0)
#define PG8_WAIT_V(n) asm volatile("s_waitcnt vmcnt(" #n ")" ::: "memory")
#define PG8_WAIT_L(n) asm volatile("s_waitcnt lgkmcnt(" #n ")" ::: "memory")
#define PG8_BAR __builtin_amdgcn_s_barrier()
#define PG8_SCHED __builtin_amdgcn_sched_barrier(0)
    Unit cur, nxt; int ui = 0;
    if (!unit_next(g, 0, G, c, cur)) return;
    f32x4 acc[2][2][4][2];
#pragma unroll
    for (int a_ = 0; a_ < 2; ++a_)
#pragma unroll
        for (int b = 0; b < 2; ++b)
#pragma unroll
            for (int m = 0; m < 4; ++m)
#pragma unroll
                for (int n = 0; n < 2; ++n) acc[a_][b][m][n] = (f32x4){0.f, 0.f, 0.f, 0.f};
    f16x8 At[4][2], B0[2][2], B1[2][2];
    const char* cA = g.A + (size_t)cur.grp * g.gsA + (size_t)cur.pm * 2 * hstepA; const char* cB = g.Bt + (size_t)cur.grp * g.gsB + (size_t)cur.pn * 2 * hstepB;
    PG8_STAGE(PG8_SB(0, 0), cB, voffB); PG8_STAGE(PG8_SB(0, 1), cB + hstepB, voffB); PG8_STAGE(PG8_SA(0, 0), cA, voffA); PG8_STAGE(PG8_SA(0, 1), cA + hstepA, voffA);
    if (wr == 1) PG8_BAR;
    PG8_WAIT_V(2); PG8_BAR;
    PG8_STAGE(PG8_SB(1, 0), cB + kstep, voffB); PG8_STAGE(PG8_SA(1, 0), cA + kstep, voffA); PG8_STAGE(PG8_SB(1, 1), cB + hstepB + kstep, voffB);
    PG8_WAIT_V(6); PG8_BAR;
    for (;;) {
        const bool has_next = unit_next(g, ui + 1, G, c, nxt);
        const char* nA = has_next ? g.A + (size_t)nxt.grp * g.gsA + (size_t)nxt.pm * 2 * hstepA : cA; const char* nB = has_next ? g.Bt + (size_t)nxt.grp * g.gsB + (size_t)nxt.pn * 2 * hstepB : cB;
        for (int t = 0; t < nt; t += 2) {
            const bool last = (t == nt - 2);
            const char* a1 = cA + (size_t)(t + 1) * kstep;
            const char* a2 = last ? nA : cA + (size_t)(t + 2) * kstep; const char* b2 = last ? nB : cB + (size_t)(t + 2) * kstep;
            const char* a3 = a2 + kstep; const char* b3 = b2 + kstep;
            PG8_LDB(B0, 0, 0); PG8_LDB(B1, 0, 1); PG8_SCHED; PG8_LDA(At, 0, 0); PG8_STAGE(PG8_SA(1, 1), a1 + hstepA, voffA);
            PG8_WAIT_V(8); PG8_WAIT_L(0); PG8_BAR; PG8_MMA(0, 0, At, B0); PG8_MMA(0, 1, At, B1); PG8_BAR; PG8_SCHED;
            PG8_LDA(At, 0, 1); PG8_STAGE(PG8_SB(0, 0), b2, voffB); PG8_STAGE(PG8_SB(0, 1), b2 + hstepB, voffB); PG8_STAGE(PG8_SA(0, 0), a2, voffA);
            PG8_WAIT_V(8); PG8_WAIT_L(0); PG8_BAR; PG8_MMA(1, 0, At, B0); PG8_MMA(1, 1, At, B1); PG8_BAR; PG8_SCHED;
            PG8_LDB(B0, 1, 0); PG8_LDB(B1, 1, 1); PG8_SCHED; PG8_LDA(At, 1, 0); PG8_STAGE(PG8_SA(0, 1), a2 + hstepA, voffA);
            PG8_WAIT_V(8); PG8_WAIT_L(0); PG8_BAR; PG8_MMA(0, 0, At, B0); PG8_MMA(0, 1, At, B1); PG8_BAR; PG8_SCHED;
            PG8_LDA(At, 1, 1); PG8_STAGE(PG8_SB(1, 0), b3, voffB); PG8_STAGE(PG8_SB(1, 1), b3 + hstepB, voffB); PG8_STAGE(PG8_SA(1, 0), a3, voffA);
            PG8_WAIT_V(8); PG8_WAIT_L(0); PG8_BAR; PG8_MMA(1, 0, At, B0); PG8_MMA(1, 1, At, B1); PG8_BAR; PG8_SCHED;
        }
        if (wr == 0) PG8_BAR;
        epilogue(mode, a, acc, cur, wr, wc, fr, fq);
        if (!has_next) break;
#pragma unroll
        for (int a_ = 0; a_ < 2; ++a_)
#pragma unroll
            for (int b = 0; b < 2; ++b)
#pragma unroll
                for (int m = 0; m < 4; ++m)
#pragma unroll
                    for (int n = 0; n < 2; ++n) acc[a_][b][m][n] = (f32x4){0.f, 0.f, 0.f, 0.f};
        cur = nxt; cA = nA; cB = nB; ++ui;
        if (wr == 1) PG8_BAR;
    }
    PG8_WAIT_V(0);
    PG8_BAR;
#undef PG8_SA
#undef PG8_SB
#undef PG8_STAGE
#undef PG8_LDA
#undef PG8_LDB
#undef PG8_MMA
#undef PG8_WAIT_V
#undef PG8_WAIT_L
#undef PG8_BAR
#undef PG8_SCHED
}

__device__ __forceinline__ int src_col_e_in(int n) { if (n < 1024 || n >= 2048) return n; const int j = (n - 1024) >> 8, w = (n - 1024) & 255; return w < 128 ? 1024 + 128 * j + w : 1536 + 128 * j + (w - 128); }
__device__ __forceinline__ int rot_dim(int p) { return p < 16 ? ((p & 1) ? 8 + (p >> 1) : (p >> 1)) : p; }
__device__ __forceinline__ int src_col_o_in(int n) {
    if (n < 1024) return (n & ~63) + rot_dim(n & 63);
    if (n < 2048) return n;
    if (n < 2304) return (n & ~63) + rot_dim(n & 63);
    if (n < 2560) return n;
    if (n < 3136) return (n & ~63) + rot_dim(n & 63);
    if (n < NO_IN) return n;
    return -1;
}
template <int MAP> __device__ __forceinline__ void conv_w(const float* src, int K, int Nsrc, h16* dst, int Nout, const float* kscale, long gtid, long gstr) {
    const long total = (long)Nout * (K / 8);
    for (long idx = gtid; idx < total; idx += gstr) {
        const int n = (int)(idx % Nout), kb = (int)(idx / Nout);
        const int sc = (MAP == 1) ? src_col_e_in(n) : (MAP == 2) ? src_col_o_in(n) : n;
        f16x8 o;
#pragma unroll
        for (int j = 0; j < 8; ++j) { float v = 0.f; if (sc >= 0) { v = src[(size_t)(8 * kb + j) * Nsrc + sc]; if (kscale) v *= kscale[8 * kb + j]; } o[j] = (h16)v; }
        *(f16x8*)(dst + (size_t)n * K + 8 * kb) = o;
    }
}

__device__ __forceinline__ void s5_setup(const Args& a, LAS unsigned char* lds, int g) {
    LAS float* F = (LAS float*)lds;
    LAS float* PWr = F, *PWi = F + 1088, *KKr = F + 2176, *KKi = F + 2240, *BBr = F + 2304, *BBi = F + 3328, *Cr = F + 4352, *Ci = F + 5376, *KT = F + 6400;
    int tid = threadIdx.x; asm volatile("" : "+v"(tid));
    const float dt = expf(a.e_log_step[g]);
    for (int e = tid; e < 1088; e += NTHREADS) {
        const int n = e / 17, j = e % 17;
        const float lr = fminf(a.e_lam_re[g * 64 + n], -1e-4f), li = a.e_lam_im[g * 64 + n];
        const float mag = expf((float)j * (lr * dt)); float s, c; sincosf((float)j * (li * dt), &s, &c);
        PWr[e] = mag * c; PWi[e] = mag * s;
    }
    if (tid < 64) {
        const int n = tid;
        const float lr = fminf(a.e_lam_re[g * 64 + n], -1e-4f), li = a.e_lam_im[g * 64 + n];
        float s, c, sh, ch; sincosf(li * dt, &s, &c); sincosf(0.5f * li * dt, &sh, &ch);
        const float em1 = expm1f(lr * dt);
        const float nr = em1 * c - 2.0f * sh * sh, ni = (em1 + 1.0f) * s, den = lr * lr + li * li;
        KKr[n] = (nr * lr + ni * li) / den; KKi[n] = (ni * lr - nr * li) / den;
        const float m16 = expf(16.0f * (lr * dt)); float s16, c16; sincosf(16.0f * (li * dt), &s16, &c16);
        float* abt = (float*)(a.ws + WS_ABT) + (size_t)(g * 64 + n) * 2; abt[0] = m16 * c16; abt[1] = m16 * s16;
    }
    __syncthreads();
    for (int e = tid; e < 1024; e += NTHREADS) {
        { const int n = e >> 4, cc = e & 15; const float br = a.e_b_re[(size_t)(g * 64 + n) * 16 + cc], bi = a.e_b_im[(size_t)(g * 64 + n) * 16 + cc];
          BBr[e] = KKr[n] * br - KKi[n] * bi; BBi[e] = KKr[n] * bi + KKi[n] * br; }
        { const int cc = e >> 6, n = e & 63; Cr[e] = a.e_c_re[(size_t)(g * 16 + cc) * 64 + n]; Ci[e] = a.e_c_im[(size_t)(g * 16 + cc) * 64 + n]; }
    }
    __syncthreads();
    for (int e = tid; e < 4096; e += NTHREADS) {
        const int tau = e >> 8, cc = (e >> 4) & 15, cp = e & 15; float s = 0.f;
        for (int n = 0; n < 64; ++n) {
            const float cr = Cr[cc * 64 + n], ci = Ci[cc * 64 + n], pr = PWr[n * 17 + tau], pi = PWi[n * 17 + tau];
            const float tr = cr * pr - ci * pi, ti = cr * pi + ci * pr;
            s += tr * BBr[n * 16 + cp] - ti * BBi[n * 16 + cp];
        }
        KT[e] = s;
    }
    __syncthreads();
    h16* MY = (h16*)(a.ws + WS_MY) + (size_t)g * (256 * 384);
    for (int e = tid; e < 256 * 48; e += NTHREADS) {
        const int row = e / 48, cg = e % 48, t = row >> 4, cc = row & 15; f16x8 o;
#pragma unroll
        for (int j = 0; j < 8; ++j) {
            const int col = cg * 8 + j; float v;
            if (col < 256) { const int tp = col >> 4, cp = col & 15; v = (t >= tp) ? KT[(t - tp) * 256 + cc * 16 + cp] : 0.f; }
            else { const int q = col - 256, n = q >> 1, ri = q & 1; const float cr = Cr[cc * 64 + n], ci = Ci[cc * 64 + n], pr = PWr[n * 17 + t + 1], pi = PWi[n * 17 + t + 1];
                   v = ri == 0 ? (cr * pr - ci * pi) : -(cr * pi + ci * pr); }
            o[j] = (h16)v;
        }
        *(f16x8*)(MY + (size_t)row * 384 + cg * 8) = o;
    }
    h16* MS = (h16*)(a.ws + WS_MS) + (size_t)g * (256 * 256);
    for (int e = tid; e < 256 * 32; e += NTHREADS) {
        const int row = e >> 5, cg = e & 31; f16x8 o;
#pragma unroll
        for (int j = 0; j < 8; ++j) {
            float v = 0.f;
            if (row < 128) { const int n = row >> 1, ri = row & 1, col = cg * 8 + j, tp = col >> 4, cp = col & 15;
                const float pr = PWr[n * 17 + 15 - tp], pi = PWi[n * 17 + 15 - tp], br = BBr[n * 16 + cp], bi = BBi[n * 16 + cp];
                v = ri == 0 ? (pr * br - pi * bi) : (pr * bi + pi * br); }
            o[j] = (h16)v;
        }
        *(f16x8*)(MS + (size_t)row * 256 + cg * 8) = o;
    }
    __syncthreads();
}

__device__ __forceinline__ void p0_prologue(const Args& a, LAS unsigned char* lds, int G, int bid) {
    int tid = threadIdx.x; asm volatile("" : "+v"(tid));
    const int lane = tid & 63, wave = tid >> 6;
    const long gtid = (long)bid * NTHREADS + tid, gstr = (long)G * NTHREADS;
    unsigned char* ws = a.ws;
    if (bid < 32) s5_setup(a, lds, bid);
    conv_w<1>(a.e_w_in, 1024, NE_IN, (h16*)(ws + WS_WE_IN), NE_IN, nullptr, gtid, gstr);
    conv_w<0>(a.e_w_glu, 512, 512, (h16*)(ws + WS_WGLU), 512, nullptr, gtid, gstr);
    conv_w<0>(a.e_w_out, 1024, 1024, (h16*)(ws + WS_WE_OUT), 1024, nullptr, gtid, gstr);
    conv_w<2>(a.o_w_in, 1024, NO_IN, (h16*)(ws + WS_WO_IN), NO_PAD, a.norm_g + 1024, gtid, gstr);
    conv_w<0>(a.o_w_out, 1024, 1024, (h16*)(ws + WS_WO_OUT), 1024, nullptr, gtid, gstr);
    for (long idx = gtid; idx < 4096 * 8; idx += gstr) {
        const int pos = (int)(idx >> 3), i = (int)(idx & 7);
        const float inv = i == 0 ? 0x1.0000000000000p+0f : i == 1 ? 0x1.8d275e0000000p-3f : i == 2 ? 0x1.3411900000000p-5f : i == 3 ? 0x1.ddee9c0000000p-8f
                        : i == 4 ? 0x1.72ba440000000p-10f : i == 5 ? 0x1.1f91f00000000p-12f : i == 6 ? 0x1.be218a0000000p-15f : 0x1.5a0f500000000p-17f;
        const float ang = (float)pos * inv; float s, c; sincosf(ang, &s, &c);
        float* r = (float*)(ws + WS_ROPE) + idx * 2; r[0] = c; r[1] = s;
    }
    h16* XN = (h16*)(ws + WS_XN);
    for (int row = bid * 8 + wave; row < MTOK; row += G * 8) {
        const f32x4* xr = (const f32x4*)(a.x + (size_t)row * 1024) + lane;
        f32x4 v[4]; float s = 0.f;
#pragma unroll
        for (int j = 0; j < 4; ++j) { v[j] = xr[64 * j]; s += (v[j][0] * v[j][0] + v[j][1] * v[j][1]) + (v[j][2] * v[j][2] + v[j][3] * v[j][3]); }
        const float rs = 1.0f / sqrtf(wave_sum(s) * (1.0f / 1024.0f) + NORM_EPS);
#pragma unroll
        for (int j = 0; j < 4; ++j) { const f32x4 gg = *((const f32x4*)a.norm_g + lane + 64 * j); f16x4 o;
            o[0] = (h16)(v[j][0] * rs * gg[0]); o[1] = (h16)(v[j][1] * rs * gg[1]); o[2] = (h16)(v[j][2] * rs * gg[2]); o[3] = (h16)(v[j][3] * rs * gg[3]);
            *((f16x4*)(XN + (size_t)row * 1024) + lane + 64 * j) = o; }
    }
}

__device__ __forceinline__ void conv_phase(const Args& a, LAS unsigned char* lds, int G, int bid) {
    LAS h16* Hs = (LAS h16*)lds;
    LAS float* Cs = (LAS float*)(lds + 65536);
    const h16* HB = (const h16*)(a.ws + WS_HB); const h16* ZB = (const h16*)(a.ws + WS_ZB); h16* YC = (h16*)(a.ws + WS_YCAT);
    int tid = threadIdx.x; asm volatile("" : "+v"(tid));
    const int lane = tid & 63, wave = tid >> 6;
    const int cp = tid & 255, th = tid >> 8;
    for (int unit = bid; unit < 1024; unit += G) {
        const int b = unit >> 7, t0 = (unit & 127) * 32;
        for (int e = tid; e < 62 * 64; e += NTHREADS) {
            const int r = e >> 6, ch = e & 63, tok = t0 - 30 + r; f16x8 v = (f16x8){0, 0, 0, 0, 0, 0, 0, 0};
            if (tok >= 0) v = *(const f16x8*)(HB + ((size_t)(b * SEQ + tok)) * 512 + ch * 8);
            *(LAS f16x8*)(Hs + r * 512 + ch * 8) = v;
        }
        __syncthreads();
        {
            float w0[31], w1[31];
#pragma unroll
            for (int j = 0; j < 31; ++j) { const f32x2 w = *(const f32x2*)(a.e_conv_w + j * 512 + 2 * cp); w0[j] = w[0]; w1[j] = w[1]; }
            const f32x2 bias = *(const f32x2*)(a.e_conv_b + 2 * cp);
            float a0[16], a1[16];
#pragma unroll
            for (int t = 0; t < 16; ++t) { a0[t] = bias[0]; a1[t] = bias[1]; }
#pragma unroll
            for (int r = 0; r < 46; ++r) {
                const f16x2 hv = *(const LAS f16x2*)(Hs + (16 * th + r) * 512 + 2 * cp);
                const float h0 = (float)hv[0], h1 = (float)hv[1];
#pragma unroll
                for (int t = 0; t < 16; ++t) { const int j = r - t; if (j >= 0 && j <= 30) { a0[t] += w0[j] * h0; a1[t] += w1[j] * h1; } }
            }
#pragma unroll
            for (int t = 0; t < 16; ++t) *(LAS f32x2*)(Cs + (16 * th + t) * 512 + 2 * cp) = (f32x2){a0[t], a1[t]};
        }
        __syncthreads();
#pragma unroll
        for (int tt = 0; tt < 4; ++tt) {
            const int t = wave * 4 + tt; const size_t tok = (size_t)b * SEQ + t0 + t;
            const f32x4 c0 = *(const LAS f32x4*)(Cs + t * 512 + lane * 8), c1 = *(const LAS f32x4*)(Cs + t * 512 + lane * 8 + 4);
            const float mean = wave_sum((c0[0] + c0[1]) + (c0[2] + c0[3]) + (c1[0] + c1[1]) + (c1[2] + c1[3])) * (1.0f / 512.0f);
            const f32x4 d0 = c0 - mean, d1 = c1 - mean;
            const float var = wave_sum((d0[0] * d0[0] + d0[1] * d0[1]) + (d0[2] * d0[2] + d0[3] * d0[3]) + (d1[0] * d1[0] + d1[1] * d1[1]) + (d1[2] * d1[2] + d1[3] * d1[3])) * (1.0f / 512.0f);
            const float rstd = 1.0f / sqrtf(var + NORM_EPS);
            const f32x4 g0 = *(const f32x4*)(a.e_ln_g + lane * 8), g1 = *(const f32x4*)(a.e_ln_g + lane * 8 + 4), b0 = *(const f32x4*)(a.e_ln_b + lane * 8), b1 = *(const f32x4*)(a.e_ln_b + lane * 8 + 4);
            const f16x8 zb = *(const f16x8*)(ZB + tok * 512 + lane * 8);
            f32x4 o0, o1;
#pragma unroll
            for (int j = 0; j < 4; ++j) { o0[j] = siluf_(d0[j] * rstd * g0[j] + b0[j]) * (float)zb[j]; o1[j] = siluf_(d1[j] * rstd * g1[j] + b1[j]) * (float)zb[4 + j]; }
            *(f16x8*)(YC + tok * 1024 + 512 + lane * 8) = cvt8(o0, o1);
        }
        __syncthreads();
    }
}

__device__ __forceinline__ void scan_phase(const Args& a, int G, int bid) {
    int tid = threadIdx.x; asm volatile("" : "+v"(tid));
    const int lane = tid & 63, wave = tid >> 6;
    if (wave != 0) return;
    for (int task = bid; task < 256; task += G) {
        const int g = task >> 3, b = task & 7, n = lane;
        const f32x2 abt = *(const f32x2*)((const float*)(a.ws + WS_ABT) + (size_t)(g * 64 + n) * 2);
        const float* se = (const float*)(a.ws + WS_SEND) + ((size_t)g * 2048 + b * 256) * 128 + 2 * n;
        h16* up = (h16*)(a.ws + WS_UA) + ((size_t)g * 2048 + b * 256) * 384 + 256 + 2 * n;
        float sr = 0.f, si = 0.f;
        for (int k0 = 0; k0 < 256; k0 += 8) {
            f32x2 e[8];
#pragma unroll
            for (int k = 0; k < 8; ++k) e[k] = *(const f32x2*)(se + (size_t)(k0 + k) * 128);
#pragma unroll
            for (int k = 0; k < 8; ++k) {
                f16x2 o; o[0] = (h16)sr; o[1] = (h16)si; *(f16x2*)(up + (size_t)(k0 + k) * 384) = o;
                const float nr = abt[0] * sr - abt[1] * si + e[k][0], ni = abt[0] * si + abt[1] * sr + e[k][1];
                sr = nr; si = ni;
            }
        }
    }
}

constexpr int SEL_CAP = 128;
__device__ __forceinline__ unsigned sortkey(float s) { const unsigned u = __float_as_uint(s); return (u & 0x80000000u) ? ~u : (u | 0x80000000u); }

template <int MODE> __device__ __forceinline__ void idx_pass(const Args& a, LAS unsigned char* lds, int b, int c, const f16x8 (&af)[4][2], const f32x4 (&wr_)[4], int wave, int lane) {
    const h16* KI = (const h16*)(a.ws + WS_KI) + (size_t)b * SEQ * 64;
    LAS unsigned* hist = (LAS unsigned*)lds;
    LAS unsigned short* mask16 = (LAS unsigned short*)lds;
    LAS unsigned long long* cand = (LAS unsigned long long*)(lds + 32768);
    LAS int* sel = (LAS int*)(lds + 131072);
    const int ntile = 4 * (c + 1);
    const int g4 = lane >> 4, odd = g4 & 1;
    const int qa = wave * 8 + (((g4 & 1) << 1) | (g4 >> 1)), qb = qa + 4;
    int bsa = 0, bsb = 0;
    if (MODE == 1) { bsa = sel[qa]; bsb = sel[qb]; }
    for (int tile = 0; tile < ntile; ++tile) {
        const h16* kp = KI + (size_t)(tile * 16 + (lane & 15)) * 64 + 8 * g4;
        const f16x8 b0 = *(const f16x8*)kp, b1 = *(const f16x8*)(kp + 32);
        float part[4];
#pragma unroll
        for (int i = 0; i < 4; ++i) {
            f32x4 d = (f32x4){0.f, 0.f, 0.f, 0.f};
            d = __builtin_amdgcn_mfma_f32_16x16x32_f16(af[i][0], b0, d, 0, 0, 0);
            d = __builtin_amdgcn_mfma_f32_16x16x32_f16(af[i][1], b1, d, 0, 0, 0);
            part[i] = wr_[i][0] * fmaxf(d[0], 0.f) + wr_[i][1] * fmaxf(d[1], 0.f) + wr_[i][2] * fmaxf(d[2], 0.f) + wr_[i][3] * fmaxf(d[3], 0.f);
        }
        const float giveA = odd ? part[0] : part[1], keepA = odd ? part[1] : part[0];
        const float giveB = odd ? part[2] : part[3], keepB = odd ? part[3] : part[2];
        const float sA = (keepA + __shfl_xor(giveA, 16)) + 0.0f, sB = (keepB + __shfl_xor(giveB, 16)) + 0.0f;
        const int key = tile * 16 + (lane & 15);
        int binA = (int)fminf(fmaxf(fmaf(sA, 32.f, 512.f), 0.f), 1023.f), binB = (int)fminf(fmaxf(fmaf(sB, 32.f, 512.f), 0.f), 1023.f);
        if (MODE == 0) {
            atomicAdd((unsigned*)(hist + qa * 512 + (binA >> 1)), (binA & 1) ? 65536u : 1u);
            atomicAdd((unsigned*)(hist + qb * 512 + (binB >> 1)), (binB & 1) ? 65536u : 1u);
        } else {
            const unsigned long long mA = __ballot(binA > bsa), mB = __ballot(binB > bsb);
            if (lane < 4) { const int q = wave * 8 + (((lane & 1) << 1) | (lane >> 1)); mask16[q * 256 + tile] = (unsigned short)(mA >> (16 * lane)); }
            else if (lane < 8) { const int l = lane - 4; const int q = wave * 8 + 4 + (((l & 1) << 1) | (l >> 1)); mask16[q * 256 + tile] = (unsigned short)(mB >> (16 * l)); }
            if (binA == bsa) { const int p = atomicAdd((int*)(sel + 128 + qa), 1); if (p < SEL_CAP) cand[qa * SEL_CAP + p] = ((unsigned long long)sortkey(sA) << 32) | (unsigned)(4095 - key); }
            if (binB == bsb) { const int p = atomicAdd((int*)(sel + 128 + qb), 1); if (p < SEL_CAP) cand[qb * SEL_CAP + p] = ((unsigned long long)sortkey(sB) << 32) | (unsigned)(4095 - key); }
        }
    }
}

__device__ __forceinline__ void idx_phase(const Args& a, LAS unsigned char* lds, int G, int bid) {
    int tid = threadIdx.x; asm volatile("" : "+v"(tid));
    const int lane = tid & 63, wave = tid >> 6;
    unsigned long long* MASK = (unsigned long long*)(a.ws + WS_MASK);
    for (long e = (long)bid * NTHREADS + tid; e < (long)NB * 256 * 4; e += (long)G * NTHREADS) {
        const int w = (int)(e & 3), q = (int)((e >> 2) & 255), b = (int)(e >> 10);
        if (w <= (q >> 6)) MASK[((size_t)b * SEQ + q) * 64 + w] = ~0ull;
    }
    if (bid >= 240) return;
    const int b = bid / 30, j = bid % 30;
    LAS unsigned* hist = (LAS unsigned*)lds;
    LAS int* sel = (LAS int*)(lds + 131072);
    LAS unsigned* mask32 = (LAS unsigned*)lds;
    LAS unsigned long long* cand = (LAS unsigned long long*)(lds + 32768);
    for (int uu = 0; uu < 2; ++uu) {
        const int c = uu == 0 ? 63 - j : 4 + j;
        const size_t tok0 = (size_t)b * SEQ + c * 64;
        f16x8 af[4][2]; f32x4 wr_[4];
        {
            const h16* QI = (const h16*)(a.ws + WS_QI); const float* WI = (const float*)(a.ws + WS_WI);
#pragma unroll
            for (int i = 0; i < 4; ++i) {
                const size_t tq = tok0 + wave * 8 + 2 * i + ((lane & 15) >> 3);
                const h16* p = QI + tq * 512 + (lane & 7) * 64 + 8 * (lane >> 4);
                af[i][0] = *(const f16x8*)p; af[i][1] = *(const f16x8*)(p + 32);
                wr_[i] = *(const f32x4*)(WI + (tok0 + wave * 8 + 2 * i + (lane >> 5)) * 8 + 4 * ((lane >> 4) & 1));
            }
        }
        for (int e = tid; e < 32768; e += NTHREADS) hist[e] = 0u;
        __syncthreads();
        idx_pass<0>(a, lds, b, c, af, wr_, wave, lane);
        __syncthreads();
        for (int ql = 0; ql < 8; ++ql) {
            const int q = wave * 8 + ql;
            unsigned cnt[16]; unsigned s = 0;
#pragma unroll
            for (int k = 0; k < 8; ++k) { const unsigned w = hist[q * 512 + lane * 8 + k]; cnt[2 * k] = w & 0xffffu; cnt[2 * k + 1] = w >> 16; s += cnt[2 * k] + cnt[2 * k + 1]; }
            unsigned suf = s;
#pragma unroll
            for (int o = 1; o < 64; o <<= 1) { const unsigned t = __shfl_down(suf, o); if (lane + o < 64) suf += t; }
            const unsigned above = suf - s;
            if (suf >= 256u && above < 256u) {
                unsigned run = above; int bs = lane * 16; int need = 1;
#pragma unroll
                for (int k = 15; k >= 0; --k) { if (run < 256u && run + cnt[k] >= 256u) { bs = lane * 16 + k; need = 256 - (int)run; } run += cnt[k]; }
                sel[q] = bs; sel[64 + q] = need;
            }
        }
        __syncthreads();
        for (int e = tid; e < 8192; e += NTHREADS) mask32[e] = 0u;
        if (tid < 64) sel[128 + tid] = 0;
        __syncthreads();
        idx_pass<1>(a, lds, b, c, af, wr_, wave, lane);
        __syncthreads();
        for (int ql = 0; ql < 8; ++ql) {
            const int q = wave * 8 + ql; int n = sel[128 + q]; if (n > SEL_CAP) n = SEL_CAP; const int need = sel[64 + q];
            const unsigned long long c0 = lane < n ? cand[q * SEL_CAP + lane] : 0ull, c1 = (lane + 64) < n ? cand[q * SEL_CAP + lane + 64] : 0ull;
            int r0 = 0, r1 = 0;
            for (int i = 0; i < n; ++i) { const unsigned long long ci = cand[q * SEL_CAP + i]; r0 += (ci > c0) ? 1 : 0; r1 += (ci > c1) ? 1 : 0; }
            if (lane < n && r0 < need) { const int key = 4095 - (int)(c0 & 0xfffu); atomicOr((unsigned*)(mask32 + q * 128 + (key >> 5)), 1u << (key & 31)); }
            if (lane + 64 < n && r1 < need) { const int key = 4095 - (int)(c1 & 0xfffu); atomicOr((unsigned*)(mask32 + q * 128 + (key >> 5)), 1u << (key & 31)); }
        }
        __syncthreads();
        for (int e = tid; e < 64 * 64; e += NTHREADS) {
            const int q = e >> 6, w = e & 63;
            if (w <= c) MASK[(tok0 + q) * 64 + w] = (unsigned long long)mask32[q * 128 + 2 * w] | ((unsigned long long)mask32[q * 128 + 2 * w + 1] << 32);
        }
        __syncthreads();
    }
}

__device__ __forceinline__ int crow(int r, int hi) { return (r & 3) + 8 * (r >> 2) + 4 * hi; }
__device__ __forceinline__ void attn_phase(const Args& a, LAS unsigned char* lds, int G, int bid) {
    int tid = threadIdx.x; asm volatile("" : "+v"(tid));
    const int lane = tid & 63, wid = tid >> 6, r32 = lane & 31, hi = lane >> 5;
    const h16* Q = (const h16*)(a.ws + WS_Q); const h16* KB = (const h16*)(a.ws + WS_KB); const h16* VB = (const h16*)(a.ws + WS_VB);
    const h16* ZS = (const h16*)(a.ws + WS_ZS); h16* AO = (h16*)(a.ws + WS_AO);
    const unsigned long long* MASK = (const unsigned long long*)(a.ws + WS_MASK);
    LAS unsigned char* Ks = lds;
    LAS unsigned char* Vs = lds + 8192;
    LAS float* wsf = (LAS float*)(lds + 16384) + wid * 64;
    constexpr float SC = 0.125f * 1.4426950408889634f;
    if (bid >= 256) return;
    const int bg = bid >> 3, s = bid & 7, b = bg >> 2, g = bg & 3;
    for (int ui = 0; ui < 8; ++ui) {
        const int k2 = ui >> 1, base = 16 * k2;
        const int c = (ui & 1) ? base + 15 - s : base + s;
        const size_t tok0 = (size_t)b * SEQ + c * 64;
        const int hh = g * 4 + (wid >> 1), qbase = 32 * (wid & 1);
        const size_t tq = tok0 + qbase + r32;
        f16x8 qr[4];
#pragma unroll
        for (int d0 = 0; d0 < 4; ++d0) qr[d0] = *(const f16x8*)(Q + tq * 1024 + hh * 64 + d0 * 16 + hi * 8);
        f32x16 o0 = {}, o1 = {};
        float mrun = -1e30f, lrun = 0.f;
        const h16* ksrc = KB + ((size_t)b * SEQ + lane) * 256 + g * 64 + wid * 8;
        const h16* vsrc = VB + ((size_t)b * SEQ + 16 * (wid & 3) + (lane >> 2)) * 256 + g * 64 + (wid >> 2) * 32 + (lane & 3) * 8;
        const int nT = c + 1;
        for (int t = 0; t < nT; ++t) {
            const f16x8 kreg = *(const f16x8*)(ksrc + (size_t)t * 64 * 256), vreg = *(const f16x8*)(vsrc + (size_t)t * 64 * 256);
            const unsigned long long mw = MASK[tq * 64 + t];
            __syncthreads();
            *(LAS f16x8*)(Ks + wid * 1024 + lane * 16) = kreg; *(LAS f16x8*)(Vs + wid * 1024 + lane * 16) = vreg;
            __syncthreads();
            f32x16 p0 = {}, p1 = {};
            {
                const LAS unsigned char* kb = Ks + hi * 1024 + r32 * 16;
#pragma unroll
                for (int d0 = 0; d0 < 4; ++d0) {
                    const f16x8 k0 = *(const LAS f16x8*)(kb + d0 * 2048), k1 = *(const LAS f16x8*)(kb + d0 * 2048 + 512);
                    p0 = __builtin_amdgcn_mfma_f32_32x32x16_f16(k0, qr[d0], p0, 0, 0, 0);
                    p1 = __builtin_amdgcn_mfma_f32_32x32x16_f16(k1, qr[d0], p1, 0, 0, 0);
                }
            }
            const unsigned mlo = (unsigned)(mw >> (4 * hi)), mhi = (unsigned)(mw >> (32 + 4 * hi));
            float mx = -INFINITY;
#pragma unroll
            for (int r = 0; r < 16; ++r) {
                const int bit = (r & 3) + 8 * (r >> 2);
                p0[r] = ((mlo >> bit) & 1u) ? p0[r] * SC : -INFINITY;
                p1[r] = ((mhi >> bit) & 1u) ? p1[r] * SC : -INFINITY;
                mx = fmaxf(mx, fmaxf(p0[r], p1[r]));
            }
            mx = fmaxf(mx, __shfl_xor(mx, 32));
            const float mnew = fmaxf(mrun, mx);
            const float alpha = __builtin_amdgcn_exp2f(mrun - mnew);
            mrun = mnew;
            float rs = 0.f;
#pragma unroll
            for (int r = 0; r < 16; ++r) { p0[r] = __builtin_amdgcn_exp2f(p0[r] - mnew); p1[r] = __builtin_amdgcn_exp2f(p1[r] - mnew); rs += p0[r] + p1[r]; }
            lrun = lrun * alpha + rs;
            if (hi == 0) wsf[r32] = alpha;
            f16x8 pa[4];
#pragma unroll
            for (int j = 0; j < 8; ++j) { pa[0][j] = (h16)p0[j]; pa[1][j] = (h16)p0[8 + j]; pa[2][j] = (h16)p1[j]; pa[3][j] = (h16)p1[8 + j]; }
#pragma unroll
            for (int k = 0; k < 4; ++k) { const f32x4 al = *(const LAS f32x4*)(wsf + 8 * k + 4 * hi);
#pragma unroll
                for (int j = 0; j < 4; ++j) { o0[4 * k + j] *= al[j]; o1[4 * k + j] *= al[j]; } }
            {
                const LAS unsigned char* vp = Vs + ((lane >> 4) & 1) * 32 + (lane & 3) * 8 + (4 * hi + ((lane & 15) >> 2)) * 64;
#pragma unroll
                for (int ks = 0; ks < 4; ++ks) {
                    const v4i16_t l0 = __builtin_amdgcn_ds_read_tr16_b64_v4i16((LAS v4i16_t*)(vp + ks * 1024)), h0 = __builtin_amdgcn_ds_read_tr16_b64_v4i16((LAS v4i16_t*)(vp + ks * 1024 + 512));
                    const v4i16_t l1 = __builtin_amdgcn_ds_read_tr16_b64_v4i16((LAS v4i16_t*)(vp + 4096 + ks * 1024)), h1 = __builtin_amdgcn_ds_read_tr16_b64_v4i16((LAS v4i16_t*)(vp + 4096 + ks * 1024 + 512));
                    typedef short s16x8 __attribute__((ext_vector_type(8)));
                    const s16x8 v0 = (s16x8){l0[0], l0[1], l0[2], l0[3], h0[0], h0[1], h0[2], h0[3]}, v1 = (s16x8){l1[0], l1[1], l1[2], l1[3], h1[0], h1[1], h1[2], h1[3]};
                    o0 = __builtin_amdgcn_mfma_f32_32x32x16_f16(pa[ks], __builtin_bit_cast(f16x8, v0), o0, 0, 0, 0);
                    o1 = __builtin_amdgcn_mfma_f32_32x32x16_f16(pa[ks], __builtin_bit_cast(f16x8, v1), o1, 0, 0, 0);
                }
            }
        }
        lrun += __shfl_xor(lrun, 32);
        __syncthreads();
        if (hi == 0) wsf[r32] = 1.0f / lrun;
        const size_t orow0 = tok0 + qbase;
#pragma unroll
        for (int r = 0; r < 16; ++r) {
            const int q = crow(r, hi); const float li = wsf[q];
            const size_t off = (orow0 + q) * 1024 + hh * 64 + r32;
            AO[off] = (h16)(o0[r] * li * (float)ZS[off]);
            AO[off + 32] = (h16)(o1[r] * li * (float)ZS[off + 32]);
        }
        __syncthreads();
    }
}

__device__ __forceinline__ void final_phase(const Args& a, int G, int bid) {
    int tid = threadIdx.x; asm volatile("" : "+v"(tid));
    const int lane = tid & 63, wave = tid >> 6;
    const float* rss = (const float*)(a.ws + WS_RSS2);
    for (int row = bid * 8 + wave; row < MTOK; row += G * 8) {
        const float rs = 1.0f / sqrtf(rss[row] * (1.0f / 1024.0f) + NORM_EPS);
        f32x4* p = (f32x4*)(a.out + (size_t)row * 1024) + lane;
#pragma unroll
        for (int j = 0; j < 4; ++j) { const f32x4 g = *((const f32x4*)a.final_g + lane + 64 * j); p[64 * j] = p[64 * j] * rs * g; }
    }
}

__global__ void __launch_bounds__(NTHREADS, 2) mega(Args a) {
    extern __shared__ __attribute__((aligned(16))) unsigned char lds_raw[];
    LAS unsigned char* lds = (LAS unsigned char*)lds_raw;
    const int G = gridDim.x, bid = blockIdx.x;
    unsigned char* ws = a.ws;
#if ONE_LAUNCH
    cg::grid_group grid = cg::this_grid();
#define SEAM() grid.sync()
#else
#define SEAM() do {} while (0)
#endif
    for (int ph = a.ph_lo; ph < a.ph_hi; ++ph) {
        GemmP g{nullptr, nullptr, 1024, 1024, 1024, 0, 0, MTOK / 256, 4, 0}; int mode = -1;
        if (ph == 1) { g.A = (const char*)(ws + WS_XN); g.Bt = (const char*)(ws + WS_WE_IN); g.nN = NE_IN / 256; mode = E_EVEN_IN; }
        else if (ph == 2) { g = GemmP{(const char*)(ws + WS_UA), (const char*)(ws + WS_MS), 384, 256, 256, 2048L * 384 * 2, 256L * 256 * 2, 8, 1, 32}; mode = E_SEND; }
        else if (ph == 4) { g = GemmP{(const char*)(ws + WS_UA), (const char*)(ws + WS_MY), 384, 384, 384, 2048L * 384 * 2, 256L * 384 * 2, 8, 1, 32}; mode = E_Y; }
        else if (ph == 5) { g = GemmP{(const char*)(ws + WS_GG), (const char*)(ws + WS_WGLU), 512, 512, 512, 0, 0, MTOK / 256, 2, 0}; mode = E_GLU; }
        else if (ph == 6) { g.A = (const char*)(ws + WS_YCAT); g.Bt = (const char*)(ws + WS_WE_OUT); mode = E_OUT_EVEN; }
        else if (ph == 7) { g.A = (const char*)(ws + WS_XN); g.Bt = (const char*)(ws + WS_WO_IN); g.nN = NO_PAD / 256; mode = E_ODD_IN; }
        else if (ph == 10) { g.A = (const char*)(ws + WS_AO); g.Bt = (const char*)(ws + WS_WO_OUT); mode = E_OUT_ODD; }
#ifdef FIXED_MODE
        if (mode >= 0 && ((PH_EN >> ph) & 1)) gemm_phase(lds, g, FIXED_MODE, a, G, bid);
#else
        if (mode >= 0 && ((PH_EN >> ph) & 1)) gemm_phase(lds, g, mode, a, G, bid);
#endif
        if (ph == 0 && (PH_EN & 1)) p0_prologue(a, lds, G, bid);
        else if (ph == 2 && (PH_EN & 4)) { __syncthreads(); conv_phase(a, lds, G, bid); }
        else if (ph == 3 && (PH_EN & 8)) scan_phase(a, G, bid);
        else if (ph == 8 && (PH_EN & 0x100)) idx_phase(a, lds, G, bid);
        else if (ph == 9 && (PH_EN & 0x200)) attn_phase(a, lds, G, bid);
        else if (ph == 11 && (PH_EN & 0x800)) final_phase(a, G, bid);
        if (ph + 1 < a.ph_hi) { SEAM(); }
    }
}

extern "C" void kernel_launch(void* const* d_in, const int* in_sizes, int n_in, void* d_out, int out_size, void* d_ws, size_t ws_size, hipStream_t stream) {
    static int grid = 0;
    if (grid == 0) {
        if (n_in != 21 || out_size != MTOK * DM || ws_size < WS_END) { fprintf(stderr, "kernel_launch: unexpected problem (n_in %d, out %d, ws %zu)\n", n_in, out_size, ws_size); grid = -1; return; }
        if (hipFuncSetAttribute((const void*)mega, hipFuncAttributeMaxDynamicSharedMemorySize, LDS_BYTES) != hipSuccess) { fprintf(stderr, "kernel_launch: hipFuncSetAttribute failed\n"); grid = -1; return; }
        int dev = 0, cus = 0, per_cu = 0;
        (void)hipGetDevice(&dev); (void)hipDeviceGetAttribute(&cus, hipDeviceAttributeMultiprocessorCount, dev);
        (void)hipOccupancyMaxActiveBlocksPerMultiprocessor(&per_cu, (const void*)mega, NTHREADS, LDS_BYTES);
        if (per_cu < 1 || cus != 256) { fprintf(stderr, "kernel_launch: occupancy %d blocks/CU, %d CUs: this kernel needs 1 block on each of 256 CUs\n", per_cu, cus); grid = -1; return; }
        grid = 256;
    }
    if (grid < 0) return;
    (void)hipMemsetAsync((char*)d_ws, 0, CTL_ZERO_BYTES, stream);
    Args a{};
    const float** ap = (const float**)&a;
    for (int i = 0; i < 21; ++i) ap[i] = (const float*)d_in[i];
    a.out = (float*)d_out; a.ws = (unsigned char*)d_ws;
#if ONE_LAUNCH
    a.ph_lo = 0; a.ph_hi = NPHASE;
    void* args[] = {&a};
    hipError_t e = hipLaunchCooperativeKernel((const void*)mega, dim3(grid), dim3(NTHREADS), args, LDS_BYTES, stream);
    if (e != hipSuccess) fprintf(stderr, "cooperative launch failed: %s\n", hipGetErrorString(e));
#else
    for (int ph = 0; ph < NPHASE; ++ph) { a.ph_lo = ph; a.ph_hi = ph + 1; hipLaunchKernelGGL(mega, dim3(grid), dim3(NTHREADS), LDS_BYTES, stream, a); }
#endif
}
```

```cpp
#include <hip/hip_runtime.h>
#include <hip/hip_cooperative_groups.h>
#include <cstdio>
#include <cstdint>
namespace cg = cooperative_groups;

#define LAS __attribute__((address_space(3)))
typedef _Float16 h16;
typedef _Float16 f16x8 __attribute__((ext_vector_type(8)));
typedef _Float16 f16x4 __attribute__((ext_vector_type(4)));
typedef _Float16 f16x2 __attribute__((ext_vector_type(2)));
typedef float f32x2 __attribute__((ext_vector_type(2)));
typedef float f32x4 __attribute__((ext_vector_type(4)));
typedef float f32x16 __attribute__((ext_vector_type(16)));
typedef unsigned u32x4 __attribute__((ext_vector_type(4)));
typedef short v4i16_t __attribute__((ext_vector_type(4)));

#ifndef PH_EN
#define PH_EN 0xFFF
#endif
#ifndef ONE_LAUNCH
#define ONE_LAUNCH 1
#endif

constexpr int NB = 8, SEQ = 4096, DM = 1024, MTOK = NB * SEQ;
constexpr int NE_IN = 2560, NO_IN = 3144, NO_PAD = 3328;
constexpr float NORM_EPS = 1e-6f;
constexpr int NTHREADS = 512;
constexpr int LDS_BYTES = 153600;
constexpr int NPHASE = 12;

constexpr size_t MiB = 1u << 20;
constexpr size_t WS_RSS1 = 0, WS_RSS2 = 128 * 1024, CTL_ZERO_BYTES = 256 * 1024;
constexpr size_t WS_ROPE = 1 * MiB;
constexpr size_t WS_ABT = 1 * MiB + 512 * 1024;
constexpr size_t WS_WE_IN = 2 * MiB;
constexpr size_t WS_WGLU = 7 * MiB;
constexpr size_t WS_WE_OUT = 8 * MiB;
constexpr size_t WS_WO_IN = 10 * MiB;
constexpr size_t WS_WO_OUT = 17 * MiB;
constexpr size_t WS_MY = 19 * MiB;
constexpr size_t WS_MS = 25 * MiB;
constexpr size_t WS_XN = 32 * MiB;
constexpr size_t WS_UA = 96 * MiB;
constexpr size_t WS_SEND = 144 * MiB;
constexpr size_t WS_ZA = 176 * MiB;
constexpr size_t WS_HB = 208 * MiB;
constexpr size_t WS_ZB = 240 * MiB;
constexpr size_t WS_GG = 272 * MiB;
constexpr size_t WS_YCAT = 304 * MiB;
constexpr size_t WS_Q = 96 * MiB;
constexpr size_t WS_ZS = 160 * MiB;
constexpr size_t WS_KB = 224 * MiB;
constexpr size_t WS_VB = 240 * MiB;
constexpr size_t WS_QI = 256 * MiB;
constexpr size_t WS_KI = 288 * MiB;
constexpr size_t WS_WI = 292 * MiB;
constexpr size_t WS_MASK = 296 * MiB;
constexpr size_t WS_AO = 312 * MiB;
constexpr size_t WS_END = 376 * MiB;

struct Args {
    const float* x; const float* norm_g; const float* e_w_in; const float* e_lam_re; const float* e_lam_im; const float* e_log_step;
    const float* e_b_re; const float* e_b_im; const float* e_c_re; const float* e_c_im; const float* e_d_skip; const float* e_w_glu; const float* e_b_glu;
    const float* e_conv_w; const float* e_conv_b; const float* e_ln_g; const float* e_ln_b; const float* e_w_out; const float* o_w_in; const float* o_w_out; const float* final_g;
    float* out; unsigned char* ws; int ph_lo, ph_hi;
};

__device__ __forceinline__ float wave_sum(float v) {
#pragma unroll
    for (int o = 1; o < 64; o <<= 1) v += __shfl_xor(v, o);
    return v;
}
__device__ __forceinline__ float sigmoidf_(float x) { return 1.0f / (1.0f + __expf(-x)); }
__device__ __forceinline__ float siluf_(float x) { return x / (1.0f + __expf(-x)); }
__device__ __forceinline__ float gelu_tanh(float x) {
    const float u = 0.7978845608028654f * (x + 0.044715f * x * x * x);
    const float e = __expf(2.0f * u);
    const float t = 1.0f - 2.0f / (e + 1.0f);
    return 0.5f * x * (1.0f + t);
}
__device__ __forceinline__ f16x8 cvt8(const f32x4 a, const f32x4 b) {
    f16x8 o; o[0] = (h16)a[0]; o[1] = (h16)a[1]; o[2] = (h16)a[2]; o[3] = (h16)a[3]; o[4] = (h16)b[0]; o[5] = (h16)b[1]; o[6] = (h16)b[2]; o[7] = (h16)b[3]; return o;
}

constexpr int BM = 256, BK = 64, HALF = 128, HTB = HALF * BK * 2, STAGE_BYTES = 8 * HTB;
__device__ __forceinline__ int lds_byte(int r, int c) { const int st = (r >> 4) * 2 + (c >> 5), rr = r & 15, cc = c & 31, ob = rr * 64 + cc * 2; return st * 1024 + (ob ^ (((ob >> 9) & 1) << 5)); }
__device__ __forceinline__ void stage_rc(int b, int& R, int& C) { const int st = b / 1024, sb = b % 1024, swz = sb ^ (((sb >> 9) & 1) << 5); R = (st >> 1) * 16 + swz / 64; C = (st & 1) * 32 + (swz % 64) / 2; }
__device__ __forceinline__ int perm32(int rho) { const int n = rho >> 4, i = rho & 15; return 8 * (i >> 2) + 4 * n + (i & 3); }

struct Unit { int pm, pn, grp; };
struct GemmP { const char* A; const char* Bt; int lda, ldb, K; long gsA, gsB; int nM, nN, ngrp; };

__device__ __forceinline__ bool unit_next(const GemmP& g, int i, int G, int c, Unit& u) {
    const long Lx = (long)i * G + c;
    const bool grouped = g.ngrp > 0;
    const int nwg = grouped ? g.nM * g.ngrp : g.nM * g.nN;
    const bool ok = Lx < (long)nwg;
    const int L0 = ok ? (int)Lx : 0;
    const int gpm = L0 % g.nM, ggrp = L0 / g.nM;
    int wgid = L0; { const int q = nwg / 8, r = nwg % 8, xcd = wgid % 8, off = wgid / 8; wgid = (xcd < r ? xcd * (q + 1) : r * (q + 1) + (xcd - r) * q) + off; }
    const int nig = 8 * g.nN, gid = wgid / nig, fm = gid * 8, gsz = (g.nM - fm) < 8 ? (g.nM - fm) : 8;
    const int dpm = fm + ((wgid % nig) % gsz), dpn = (wgid % nig) / gsz;
    Unit r; r.pm = grouped ? gpm : dpm; r.pn = grouped ? 0 : dpn; r.grp = grouped ? ggrp : 0;
    u = r; return ok;
}

enum EpiMode { E_EVEN_IN = 0, E_SEND = 1, E_Y = 2, E_GLU = 3, E_OUT_EVEN = 4, E_ODD_IN = 5, E_OUT_ODD = 6 };

__device__ __forceinline__ void epilogue(const int mode, const Args& a, const f32x4 (&acc)[2][2][4][2], const Unit& u, int wr, int wc, int fr, int fq) {
    asm volatile("" : "+v"(fr), "+v"(fq));
    unsigned char* ws = a.ws;
    const int colw = 32 * wc + 8 * fq;
    if (mode == E_EVEN_IN) {
        const int pn = u.pn;
        if (pn >= 4 && pn < 8) {
            h16* HB = (h16*)(ws + WS_HB);
#pragma unroll
            for (int ai = 0; ai < 2; ++ai)
#pragma unroll
                for (int m = 0; m < 4; ++m) {
                    const int row = u.pm * BM + ai * HALF + wr * 64 + m * 16 + fr;
                    f32x4 o0, o1;
#pragma unroll
                    for (int j = 0; j < 4; ++j) { o0[j] = acc[ai][0][m][0][j] * sigmoidf_(acc[ai][1][m][0][j]); o1[j] = acc[ai][0][m][1][j] * sigmoidf_(acc[ai][1][m][1][j]); }
                    *(f16x8*)(HB + (size_t)row * 512 + (pn - 4) * 128 + colw) = cvt8(o0, o1);
                }
        } else {
#pragma unroll
            for (int ai = 0; ai < 2; ++ai)
#pragma unroll
                for (int m = 0; m < 4; ++m) {
                    const int row = u.pm * BM + ai * HALF + wr * 64 + m * 16 + fr;
#pragma unroll
                    for (int bj = 0; bj < 2; ++bj) {
                        const int col = pn * BM + bj * HALF + colw;
                        f32x4 v0 = acc[ai][bj][m][0], v1 = acc[ai][bj][m][1];
                        if (pn < 2) {
                            const int g = col >> 4;
                            h16* p = (h16*)(ws + WS_UA) + (size_t)g * (2048 * 384) + (size_t)(row >> 4) * 384 + (row & 15) * 16 + (col & 15);
                            *(f16x8*)p = cvt8(v0, v1);
                        } else {
#pragma unroll
                            for (int j = 0; j < 4; ++j) { v0[j] = siluf_(v0[j]); v1[j] = siluf_(v1[j]); }
                            if (pn < 4) *(f16x8*)((h16*)(ws + WS_ZA) + (size_t)row * 512 + (col - 512)) = cvt8(v0, v1);
                            else        *(f16x8*)((h16*)(ws + WS_ZB) + (size_t)row * 512 + (col - 2048)) = cvt8(v0, v1);
                        }
                    }
                }
        }
    } else if (mode == E_SEND) {
        float* SE = (float*)(ws + WS_SEND) + (size_t)u.grp * (2048 * 128);
#pragma unroll
        for (int ai = 0; ai < 2; ++ai)
#pragma unroll
            for (int m = 0; m < 4; ++m) {
                const int row = u.pm * BM + ai * HALF + wr * 64 + m * 16 + fr;
                float* p = SE + (size_t)row * 128 + colw;
                *(f32x4*)p = acc[ai][0][m][0]; *(f32x4*)(p + 4) = acc[ai][0][m][1];
            }
    } else if (mode == E_Y) {
        const h16* UA = (const h16*)(ws + WS_UA) + (size_t)u.grp * (2048 * 384);
        h16* GG = (h16*)(ws + WS_GG);
#pragma unroll
        for (int bj = 0; bj < 2; ++bj) {
            const int col = bj * HALF + colw, t = col >> 4, c0 = col & 15;
            const f32x4 d0 = *(const f32x4*)(a.e_d_skip + u.grp * 16 + c0), d1 = *(const f32x4*)(a.e_d_skip + u.grp * 16 + c0 + 4);
#pragma unroll
            for (int ai = 0; ai < 2; ++ai)
#pragma unroll
                for (int m = 0; m < 4; ++m) {
                    const int row = u.pm * BM + ai * HALF + wr * 64 + m * 16 + fr;
                    const f16x8 uu = *(const f16x8*)(UA + (size_t)row * 384 + col);
                    f32x4 o0, o1;
#pragma unroll
                    for (int j = 0; j < 4; ++j) { o0[j] = gelu_tanh(acc[ai][bj][m][0][j] + (float)uu[j] * d0[j]); o1[j] = gelu_tanh(acc[ai][bj][m][1][j] + (float)uu[4 + j] * d1[j]); }
                    *(f16x8*)(GG + ((size_t)row * 16 + t) * 512 + u.grp * 16 + c0) = cvt8(o0, o1);
                }
        }
    } else if (mode == E_GLU) {
        const h16* GG = (const h16*)(ws + WS_GG); const h16* ZA = (const h16*)(ws + WS_ZA); h16* YC = (h16*)(ws + WS_YCAT);
#pragma unroll
        for (int bj = 0; bj < 2; ++bj) {
            const int col = u.pn * BM + bj * HALF + colw;
            const f32x4 b0 = *(const f32x4*)(a.e_b_glu + col), b1 = *(const f32x4*)(a.e_b_glu + col + 4);
#pragma unroll
            for (int ai = 0; ai < 2; ++ai)
#pragma unroll
                for (int m = 0; m < 4; ++m) {
                    const int row = u.pm * BM + ai * HALF + wr * 64 + m * 16 + fr;
                    const f16x8 gg = *(const f16x8*)(GG + (size_t)row * 512 + col), za = *(const f16x8*)(ZA + (size_t)row * 512 + col);
                    f32x4 o0, o1;
#pragma unroll
                    for (int j = 0; j < 4; ++j) { o0[j] = (float)gg[j] * sigmoidf_(acc[ai][bj][m][0][j] + b0[j]) * (float)za[j]; o1[j] = (float)gg[4 + j] * sigmoidf_(acc[ai][bj][m][1][j] + b1[j]) * (float)za[4 + j]; }
                    *(f16x8*)(YC + (size_t)row * 1024 + col) = cvt8(o0, o1);
                }
        }
    } else if (mode == E_OUT_EVEN || mode == E_OUT_ODD) {
        const float* base = (mode == E_OUT_EVEN) ? a.x : a.out;
        float* rss = (float*)(ws + (mode == E_OUT_EVEN ? WS_RSS1 : WS_RSS2));
        h16* H1 = (h16*)(ws + WS_XN);
#pragma unroll
        for (int ai = 0; ai < 2; ++ai)
#pragma unroll
            for (int m = 0; m < 4; ++m) {
                const int row = u.pm * BM + ai * HALF + wr * 64 + m * 16 + fr;
                float ss = 0.f;
#pragma unroll
                for (int bj = 0; bj < 2; ++bj) {
                    const int col = u.pn * BM + bj * HALF + colw;
                    const size_t off = (size_t)row * 1024 + col;
                    const f32x4 x0 = *(const f32x4*)(base + off), x1 = *(const f32x4*)(base + off + 4);
                    const f32x4 h0 = x0 + acc[ai][bj][m][0], h1 = x1 + acc[ai][bj][m][1];
                    *(f32x4*)(a.out + off) = h0; *(f32x4*)(a.out + off + 4) = h1;
                    if (mode == E_OUT_EVEN) *(f16x8*)(H1 + off) = cvt8(h0, h1);
#pragma unroll
                    for (int j = 0; j < 4; ++j) ss += h0[j] * h0[j] + h1[j] * h1[j];
                }
                ss += __shfl_xor(ss, 16); ss += __shfl_xor(ss, 32);
                if (fq == 0) atomicAdd(rss + row, ss);
            }
    } else if (mode == E_ODD_IN) {
        const int pn = u.pn;
        const float* rss = (const float*)(ws + WS_RSS1);
        const float* ROPE = (const float*)(ws + WS_ROPE);
#pragma unroll
        for (int ai = 0; ai < 2; ++ai)
#pragma unroll
            for (int m = 0; m < 4; ++m) {
                const int row = u.pm * BM + ai * HALF + wr * 64 + m * 16 + fr;
                const float rs = 1.0f / sqrtf(rss[row] * (1.0f / 1024.0f) + NORM_EPS);
                const int pos = row & (SEQ - 1);
#pragma unroll
                for (int bj = 0; bj < 2; ++bj) {
                    const int col = pn * BM + bj * HALF + colw;
                    f32x4 v0 = acc[ai][bj][m][0] * rs, v1 = acc[ai][bj][m][1] * rs;
                    const bool ropeT = (pn < 4) || pn == 8 || pn == 10 || pn == 11 || (pn == 12 && col < 3072 + 64);
                    if (ropeT && (col & 63) < 16) {
                        const int i0 = (col & 63) >> 1;
                        const f32x4 cs0 = *(const f32x4*)(ROPE + pos * 16 + i0 * 2), cs1 = *(const f32x4*)(ROPE + pos * 16 + i0 * 2 + 4);
                        f32x4 r0, r1;
                        r0[0] = v0[0] * cs0[0] - v0[1] * cs0[1]; r0[1] = v0[0] * cs0[1] + v0[1] * cs0[0];
                        r0[2] = v0[2] * cs0[2] - v0[3] * cs0[3]; r0[3] = v0[2] * cs0[3] + v0[3] * cs0[2];
                        r1[0] = v1[0] * cs1[0] - v1[1] * cs1[1]; r1[1] = v1[0] * cs1[1] + v1[1] * cs1[0];
                        r1[2] = v1[2] * cs1[2] - v1[3] * cs1[3]; r1[3] = v1[2] * cs1[3] + v1[3] * cs1[2];
                        v0 = r0; v1 = r1;
                    }
                    if (pn < 4) *(f16x8*)((h16*)(ws + WS_Q) + (size_t)row * 1024 + col) = cvt8(v0, v1);
                    else if (pn < 8) {
#pragma unroll
                        for (int j = 0; j < 4; ++j) { v0[j] = siluf_(v0[j]); v1[j] = siluf_(v1[j]); }
                        *(f16x8*)((h16*)(ws + WS_ZS) + (size_t)row * 1024 + (col - 1024)) = cvt8(v0, v1);
                    } else if (pn == 8) *(f16x8*)((h16*)(ws + WS_KB) + (size_t)row * 256 + (col - 2048)) = cvt8(v0, v1);
                    else if (pn == 9) *(f16x8*)((h16*)(ws + WS_VB) + (size_t)row * 256 + (col - 2304)) = cvt8(v0, v1);
                    else if (pn < 12) *(f16x8*)((h16*)(ws + WS_QI) + (size_t)row * 512 + (col - 2560)) = cvt8(v0, v1);
                    else {
                        const int cl = col - 3072;
                        if (cl < 64) *(f16x8*)((h16*)(ws + WS_KI) + (size_t)row * 64 + cl) = cvt8(v0, v1);
                        else if (cl == 64) { float* w = (float*)(ws + WS_WI) + (size_t)row * 8; *(f32x4*)w = v0 * 0.04419417382415922f; *(f32x4*)(w + 4) = v1 * 0.04419417382415922f; }
                    }
                }
            }
    }
}

__device__ __forceinline__ void gemm_phase(LAS unsigned char* lds, const GemmP g, const int mode, const Args& a, const int G, const int c) {
    int tid = threadIdx.x; asm volatile("" : "+v"(tid));
    const int wid = __builtin_amdgcn_readfirstlane(tid >> 6), lane = tid & 63, wr = wid >> 2, wc = wid & 3, fr = lane & 15, fq = lane >> 4;
    const int nt = g.K / BK;
    unsigned voffA[2], voffB[2];
#pragma unroll
    for (int i = 0; i < 2; ++i) { int R, C; stage_rc(tid * 16 + i * 8192, R, C); const int Rb = (R & ~31) + perm32(R & 31);
        voffA[i] = (unsigned)(R * g.lda + C) * 2u; voffB[i] = (unsigned)(Rb * g.ldb + C) * 2u; }
    const size_t kstep = (size_t)(BK * 2);
    const size_t hstepA = (size_t)HALF * g.lda * 2, hstepB = (size_t)HALF * g.ldb * 2;
    const unsigned ldsw = (unsigned)wid * 1024u;
    const int aoff = lds_byte(wr * 64 + fr, fq * 8), boff = lds_byte(wc * 32 + fr, fq * 8);
#define PG8_SA(b, h) (((b) * 2 + (h)) * HTB)
#define PG8_SB(b, h) ((4 + (b) * 2 + (h)) * HTB)
#define PG8_STAGE(bufoff, gbase, voff) do { _Pragma("unroll") for (int _i = 0; _i < 2; ++_i) \
        __builtin_amdgcn_global_load_lds((const unsigned*)((const char*)(gbase) + (voff)[_i]), (LAS unsigned*)(lds + (bufoff) + ldsw + _i * 8192), 16, 0, 0); } while (0)
#define PG8_LDA(dst, b, h) do { _Pragma("unroll") for (int m = 0; m < 4; ++m) _Pragma("unroll") for (int k = 0; k < 2; ++k) dst[m][k] = *(const LAS f16x8*)(lds + PG8_SA(b, h) + aoff + m * 2048 + k * 1024); } while (0)
#define PG8_LDB(dst, b, h) do { _Pragma("unroll") for (int n = 0; n < 2; ++n) _Pragma("unroll") for (int k = 0; k < 2; ++k) dst[n][k] = *(const LAS f16x8*)(lds + PG8_SB(b, h) + boff + n * 2048 + k * 1024); } while (0)
#define PG8_MMA(ai, bj, At, Bt) do { __builtin_amdgcn_s_setprio(1); _Pragma("unroll") for (int m = 0; m < 4; ++m) _Pragma("unroll") for (int n = 0; n < 2; ++n) _Pragma("unroll") for (int k = 0; k < 2; ++k) \
        acc[ai][bj][m][n] = __builtin_amdgcn_mfma_f32_16x16x32_f16(Bt[n][k], At[m][k], acc[ai][bj][m][n], 0, 0, 0); __builtin_amdgcn_s_setprio(0); } while (0)
#define PG8_WAIT_V(n) asm volatile("s_waitcnt vmcnt(" #n ")" ::: "memory")
#define PG8_WAIT_L(n) asm volatile("s_waitcnt lgkmcnt(" #n ")" ::: "memory")
#define PG8_BAR __builtin_amdgcn_s_barrier()
#define PG8_SCHED __builtin_amdgcn_sched_barrier(0)
    Unit cur, nxt; int ui = 0;
    if (!unit_next(g, 0, G, c, cur)) return;
    f32x4 acc[2][2][4][2];
#pragma unroll
    for (int a_ = 0; a_ < 2; ++a_)
#pragma unroll
        for (int b = 0; b < 2; ++b)
#pragma unroll
            for (int m = 0; m < 4; ++m)
#pragma unroll
                for (int n = 0; n < 2; ++n) acc[a_][b][m][n] = (f32x4){0.f, 0.f, 0.f, 0.f};
    f16x8 At[4][2], B0[2][2], B1[2][2];
    const char* cA = g.A + (size_t)cur.grp * g.gsA + (size_t)cur.pm * 2 * hstepA; const char* cB = g.Bt + (size_t)cur.grp * g.gsB + (size_t)cur.pn * 2 * hstepB;
    PG8_STAGE(PG8_SB(0, 0), cB, voffB); PG8_STAGE(PG8_SB(0, 1), cB + hstepB, voffB); PG8_STAGE(PG8_SA(0, 0), cA, voffA); PG8_STAGE(PG8_SA(0, 1), cA + hstepA, voffA);
    if (wr == 1) PG8_BAR;
    PG8_WAIT_V(2); PG8_BAR;
    PG8_STAGE(PG8_SB(1, 0), cB + kstep, voffB); PG8_STAGE(PG8_SA(1, 0), cA + kstep, voffA); PG8_STAGE(PG8_SB(1, 1), cB + hstepB + kstep, voffB);
    PG8_WAIT_V(6); PG8_BAR;
    for (;;) {
        const bool has_next = unit_next(g, ui + 1, G, c, nxt);
        const char* nA = has_next ? g.A + (size_t)nxt.grp * g.gsA + (size_t)nxt.pm * 2 * hstepA : cA; const char* nB = has_next ? g.Bt + (size_t)nxt.grp * g.gsB + (size_t)nxt.pn * 2 * hstepB : cB;
        for (int t = 0; t < nt; t += 2) {
            const bool last = (t == nt - 2);
            const char* a1 = cA + (size_t)(t + 1) * kstep;
            const char* a2 = last ? nA : cA + (size_t)(t + 2) * kstep; const char* b2 = last ? nB : cB + (size_t)(t + 2) * kstep;
            const char* a3 = a2 + kstep; const char* b3 = b2 + kstep;
            PG8_LDB(B0, 0, 0); PG8_LDB(B1, 0, 1); PG8_SCHED; PG8_LDA(At, 0, 0); PG8_STAGE(PG8_SA(1, 1), a1 + hstepA, voffA);
            PG8_WAIT_V(8); PG8_WAIT_L(0); PG8_BAR; PG8_MMA(0, 0, At, B0); PG8_MMA(0, 1, At, B1); PG8_BAR; PG8_SCHED;
            PG8_LDA(At, 0, 1); PG8_STAGE(PG8_SB(0, 0), b2, voffB); PG8_STAGE(PG8_SB(0, 1), b2 + hstepB, voffB); PG8_STAGE(PG8_SA(0, 0), a2, voffA);
            PG8_WAIT_V(8); PG8_WAIT_L(0); PG8_BAR; PG8_MMA(1, 0, At, B0); PG8_MMA(1, 1, At, B1); PG8_BAR; PG8_SCHED;
            PG8_LDB(B0, 1, 0); PG8_LDB(B1, 1, 1); PG8_SCHED; PG8_LDA(At, 1, 0); PG8_STAGE(PG8_SA(0, 1), a2 + hstepA, voffA);
            PG8_WAIT_V(8); PG8_WAIT_L(0); PG8_BAR; PG8_MMA(0, 0, At, B0); PG8_MMA(0, 1, At, B1); PG8_BAR; PG8_SCHED;
            PG8_LDA(At, 1, 1); PG8_STAGE(PG8_SB(1, 0), b3, voffB); PG8_STAGE(PG8_SB(1, 1), b3 + hstepB, voffB); PG8_STAGE(PG8_SA(1, 0), a3, voffA);
            PG8_WAIT_V(8); PG8_WAIT_L(0); PG8_BAR; PG8_MMA(1, 0, At, B0); PG8_MMA(1, 1, At, B1); PG8_BAR; PG8_SCHED;
        }
        if (wr == 0) PG8_BAR;
        epilogue(mode, a, acc, cur, wr, wc, fr, fq);
        if (!has_next) break;
#pragma unroll
        for (int a_ = 0; a_ < 2; ++a_)
#pragma unroll
            for (int b = 0; b < 2; ++b)
#pragma unroll
                for (int m = 0; m < 4; ++m)
#pragma unroll
                    for (int n = 0; n < 2; ++n) acc[a_][b][m][n] = (f32x4){0.f, 0.f, 0.f, 0.f};
        cur = nxt; cA = nA; cB = nB; ++ui;
        if (wr == 1) PG8_BAR;
    }
    PG8_WAIT_V(0);
    PG8_BAR;
#undef PG8_SA
#undef PG8_SB
#undef PG8_STAGE
#undef PG8_LDA
#undef PG8_LDB
#undef PG8_MMA
#undef PG8_WAIT_V
#undef PG8_WAIT_L
#undef PG8_BAR
#undef PG8_SCHED
}

__device__ __forceinline__ int src_col_e_in(int n) { if (n < 1024 || n >= 2048) return n; const int j = (n - 1024) >> 8, w = (n - 1024) & 255; return w < 128 ? 1024 + 128 * j + w : 1536 + 128 * j + (w - 128); }
__device__ __forceinline__ int rot_dim(int p) { return p < 16 ? ((p & 1) ? 8 + (p >> 1) : (p >> 1)) : p; }
__device__ __forceinline__ int src_col_o_in(int n) {
    if (n < 1024) return (n & ~63) + rot_dim(n & 63);
    if (n < 2048) return n;
    if (n < 2304) return (n & ~63) + rot_dim(n & 63);
    if (n < 2560) return n;
    if (n < 3136) return (n & ~63) + rot_dim(n & 63);
    if (n < NO_IN) return n;
    return -1;
}
template <int MAP> __device__ __forceinline__ void conv_w(const float* src, int K, int Nsrc, h16* dst, int Nout, const float* kscale, long gtid, long gstr) {
    const long total = (long)Nout * (K / 8);
    for (long idx = gtid; idx < total; idx += gstr) {
        const int n = (int)(idx % Nout), kb = (int)(idx / Nout);
        const int sc = (MAP == 1) ? src_col_e_in(n) : (MAP == 2) ? src_col_o_in(n) : n;
        f16x8 o;
#pragma unroll
        for (int j = 0; j < 8; ++j) { float v = 0.f; if (sc >= 0) { v = src[(size_t)(8 * kb + j) * Nsrc + sc]; if (kscale) v *= kscale[8 * kb + j]; } o[j] = (h16)v; }
        *(f16x8*)(dst + (size_t)n * K + 8 * kb) = o;
    }
}

__device__ __forceinline__ void s5_setup(const Args& a, LAS unsigned char* lds, int g) {
    LAS float* F = (LAS float*)lds;
    LAS float* PWr = F, *PWi = F + 1088, *KKr = F + 2176, *KKi = F + 2240, *BBr = F + 2304, *BBi = F + 3328, *Cr = F + 4352, *Ci = F + 5376, *KT = F + 6400;
    int tid = threadIdx.x; asm volatile("" : "+v"(tid));
    const float dt = expf(a.e_log_step[g]);
    for (int e = tid; e < 1088; e += NTHREADS) {
        const int n = e / 17, j = e % 17;
        const float lr = fminf(a.e_lam_re[g * 64 + n], -1e-4f), li = a.e_lam_im[g * 64 + n];
        const float mag = expf((float)j * (lr * dt)); float s, c; sincosf((float)j * (li * dt), &s, &c);
        PWr[e] = mag * c; PWi[e] = mag * s;
    }
    if (tid < 64) {
        const int n = tid;
        const float lr = fminf(a.e_lam_re[g * 64 + n], -1e-4f), li = a.e_lam_im[g * 64 + n];
        float s, c, sh, ch; sincosf(li * dt, &s, &c); sincosf(0.5f * li * dt, &sh, &ch);
        const float em1 = expm1f(lr * dt);
        const float nr = em1 * c - 2.0f * sh * sh, ni = (em1 + 1.0f) * s, den = lr * lr + li * li;
        KKr[n] = (nr * lr + ni * li) / den; KKi[n] = (ni * lr - nr * li) / den;
        const float m16 = expf(16.0f * (lr * dt)); float s16, c16; sincosf(16.0f * (li * dt), &s16, &c16);
        float* abt = (float*)(a.ws + WS_ABT) + (size_t)(g * 64 + n) * 2; abt[0] = m16 * c16; abt[1] = m16 * s16;
    }
    __syncthreads();
    for (int e = tid; e < 1024; e += NTHREADS) {
        { const int n = e >> 4, cc = e & 15; const float br = a.e_b_re[(size_t)(g * 64 + n) * 16 + cc], bi = a.e_b_im[(size_t)(g * 64 + n) * 16 + cc];
          BBr[e] = KKr[n] * br - KKi[n] * bi; BBi[e] = KKr[n] * bi + KKi[n] * br; }
        { const int cc = e >> 6, n = e & 63; Cr[e] = a.e_c_re[(size_t)(g * 16 + cc) * 64 + n]; Ci[e] = a.e_c_im[(size_t)(g * 16 + cc) * 64 + n]; }
    }
    __syncthreads();
    for (int e = tid; e < 4096; e += NTHREADS) {
        const int tau = e >> 8, cc = (e >> 4) & 15, cp = e & 15; float s = 0.f;
        for (int n = 0; n < 64; ++n) {
            const float cr = Cr[cc * 64 + n], ci = Ci[cc * 64 + n], pr = PWr[n * 17 + tau], pi = PWi[n * 17 + tau];
            const float tr = cr * pr - ci * pi, ti = cr * pi + ci * pr;
            s += tr * BBr[n * 16 + cp] - ti * BBi[n * 16 + cp];
        }
        KT[e] = s;
    }
    __syncthreads();
    h16* MY = (h16*)(a.ws + WS_MY) + (size_t)g * (256 * 384);
    for (int e = tid; e < 256 * 48; e += NTHREADS) {
        const int row = e / 48, cg = e % 48, t = row >> 4, cc = row & 15; f16x8 o;
#pragma unroll
        for (int j = 0; j < 8; ++j) {
            const int col = cg * 8 + j; float v;
            if (col < 256) { const int tp = col >> 4, cp = col & 15; v = (t >= tp) ? KT[(t - tp) * 256 + cc * 16 + cp] : 0.f; }
            else { const int q = col - 256, n = q >> 1, ri = q & 1; const float cr = Cr[cc * 64 + n], ci = Ci[cc * 64 + n], pr = PWr[n * 17 + t + 1], pi = PWi[n * 17 + t + 1];
                   v = ri == 0 ? (cr * pr - ci * pi) : -(cr * pi + ci * pr); }
            o[j] = (h16)v;
        }
        *(f16x8*)(MY + (size_t)row * 384 + cg * 8) = o;
    }
    h16* MS = (h16*)(a.ws + WS_MS) + (size_t)g * (256 * 256);
    for (int e = tid; e < 256 * 32; e += NTHREADS) {
        const int row = e >> 5, cg = e & 31; f16x8 o;
#pragma unroll
        for (int j = 0; j < 8; ++j) {
            float v = 0.f;
            if (row < 128) { const int n = row >> 1, ri = row & 1, col = cg * 8 + j, tp = col >> 4, cp = col & 15;
                const float pr = PWr[n * 17 + 15 - tp], pi = PWi[n * 17 + 15 - tp], br = BBr[n * 16 + cp], bi = BBi[n * 16 + cp];
                v = ri == 0 ? (pr * br - pi * bi) : (pr * bi + pi * br); }
            o[j] = (h16)v;
        }
        *(f16x8*)(MS + (size_t)row * 256 + cg * 8) = o;
    }
    __syncthreads();
}

__device__ __forceinline__ void p0_prologue(const Args& a, LAS unsigned char* lds, int G, int bid) {
    int tid = threadIdx.x; asm volatile("" : "+v"(tid));
    const int lane = tid & 63, wave = tid >> 6;
    const long gtid = (long)bid * NTHREADS + tid, gstr = (long)G * NTHREADS;
    unsigned char* ws = a.ws;
    if (bid < 32) s5_setup(a, lds, bid);
    conv_w<1>(a.e_w_in, 1024, NE_IN, (h16*)(ws + WS_WE_IN), NE_IN, nullptr, gtid, gstr);
    conv_w<0>(a.e_w_glu, 512, 512, (h16*)(ws + WS_WGLU), 512, nullptr, gtid, gstr);
    conv_w<0>(a.e_w_out, 1024, 1024, (h16*)(ws + WS_WE_OUT), 1024, nullptr, gtid, gstr);
    conv_w<2>(a.o_w_in, 1024, NO_IN, (h16*)(ws + WS_WO_IN), NO_PAD, a.norm_g + 1024, gtid, gstr);
    conv_w<0>(a.o_w_out, 1024, 1024, (h16*)(ws + WS_WO_OUT), 1024, nullptr, gtid, gstr);
    for (long idx = gtid; idx < 4096 * 8; idx += gstr) {
        const int pos = (int)(idx >> 3), i = (int)(idx & 7);
        const float inv = i == 0 ? 0x1.0000000000000p+0f : i == 1 ? 0x1.8d275e0000000p-3f : i == 2 ? 0x1.3411900000000p-5f : i == 3 ? 0x1.ddee9c0000000p-8f
                        : i == 4 ? 0x1.72ba440000000p-10f : i == 5 ? 0x1.1f91f00000000p-12f : i == 6 ? 0x1.be218a0000000p-15f : 0x1.5a0f500000000p-17f;
        const float ang = (float)pos * inv; float s, c; sincosf(ang, &s, &c);
        float* r = (float*)(ws + WS_ROPE) + idx * 2; r[0] = c; r[1] = s;
    }
    h16* XN = (h16*)(ws + WS_XN);
    for (int row = bid * 8 + wave; row < MTOK; row += G * 8) {
        const f32x4* xr = (const f32x4*)(a.x + (size_t)row * 1024) + lane;
        f32x4 v[4]; float s = 0.f;
#pragma unroll
        for (int j = 0; j < 4; ++j) { v[j] = xr[64 * j]; s += (v[j][0] * v[j][0] + v[j][1] * v[j][1]) + (v[j][2] * v[j][2] + v[j][3] * v[j][3]); }
        const float rs = 1.0f / sqrtf(wave_sum(s) * (1.0f / 1024.0f) + NORM_EPS);
#pragma unroll
        for (int j = 0; j < 4; ++j) { const f32x4 gg = *((const f32x4*)a.norm_g + lane + 64 * j); f16x4 o;
            o[0] = (h16)(v[j][0] * rs * gg[0]); o[1] = (h16)(v[j][1] * rs * gg[1]); o[2] = (h16)(v[j][2] * rs * gg[2]); o[3] = (h16)(v[j][3] * rs * gg[3]);
            *((f16x4*)(XN + (size_t)row * 1024) + lane + 64 * j) = o; }
    }
}

__device__ __forceinline__ void conv_phase(const Args& a, LAS unsigned char* lds, int G, int bid) {
    LAS h16* Hs = (LAS h16*)lds;
    LAS float* Cs = (LAS float*)(lds + 65536);
    const h16* HB = (const h16*)(a.ws + WS_HB); const h16* ZB = (const h16*)(a.ws + WS_ZB); h16* YC = (h16*)(a.ws + WS_YCAT);
    int tid = threadIdx.x; asm volatile("" : "+v"(tid));
    const int lane = tid & 63, wave = tid >> 6;
    const int cp = tid & 255, th = tid >> 8;
    for (int unit = bid; unit < 1024; unit += G) {
        const int b = unit >> 7, t0 = (unit & 127) * 32;
        for (int e = tid; e < 62 * 64; e += NTHREADS) {
            const int r = e >> 6, ch = e & 63, tok = t0 - 30 + r; f16x8 v = (f16x8){0, 0, 0, 0, 0, 0, 0, 0};
            if (tok >= 0) v = *(const f16x8*)(HB + ((size_t)(b * SEQ + tok)) * 512 + ch * 8);
            *(LAS f16x8*)(Hs + r * 512 + ch * 8) = v;
        }
        __syncthreads();
        {
            float w0[31], w1[31];
#pragma unroll
            for (int j = 0; j < 31; ++j) { const f32x2 w = *(const f32x2*)(a.e_conv_w + j * 512 + 2 * cp); w0[j] = w[0]; w1[j] = w[1]; }
            const f32x2 bias = *(const f32x2*)(a.e_conv_b + 2 * cp);
            float a0[16], a1[16];
#pragma unroll
            for (int t = 0; t < 16; ++t) { a0[t] = bias[0]; a1[t] = bias[1]; }
#pragma unroll
            for (int r = 0; r < 46; ++r) {
                const f16x2 hv = *(const LAS f16x2*)(Hs + (16 * th + r) * 512 + 2 * cp);
                const float h0 = (float)hv[0], h1 = (float)hv[1];
#pragma unroll
                for (int t = 0; t < 16; ++t) { const int j = r - t; if (j >= 0 && j <= 30) { a0[t] += w0[j] * h0; a1[t] += w1[j] * h1; } }
            }
#pragma unroll
            for (int t = 0; t < 16; ++t) *(LAS f32x2*)(Cs + (16 * th + t) * 512 + 2 * cp) = (f32x2){a0[t], a1[t]};
        }
        __syncthreads();
#pragma unroll
        for (int tt = 0; tt < 4; ++tt) {
            const int t = wave * 4 + tt; const size_t tok = (size_t)b * SEQ + t0 + t;
            const f32x4 c0 = *(const LAS f32x4*)(Cs + t * 512 + lane * 8), c1 = *(const LAS f32x4*)(Cs + t * 512 + lane * 8 + 4);
            const float mean = wave_sum((c0[0] + c0[1]) + (c0[2] + c0[3]) + (c1[0] + c1[1]) + (c1[2] + c1[3])) * (1.0f / 512.0f);
            const f32x4 d0 = c0 - mean, d1 = c1 - mean;
            const float var = wave_sum((d0[0] * d0[0] + d0[1] * d0[1]) + (d0[2] * d0[2] + d0[3] * d0[3]) + (d1[0] * d1[0] + d1[1] * d1[1]) + (d1[2] * d1[2] + d1[3] * d1[3])) * (1.0f / 512.0f);
            const float rstd = 1.0f / sqrtf(var + NORM_EPS);
            const f32x4 g0 = *(const f32x4*)(a.e_ln_g + lane * 8), g1 = *(const f32x4*)(a.e_ln_g + lane * 8 + 4), b0 = *(const f32x4*)(a.e_ln_b + lane * 8), b1 = *(const f32x4*)(a.e_ln_b + lane * 8 + 4);
            const f16x8 zb = *(const f16x8*)(ZB + tok * 512 + lane * 8);
            f32x4 o0, o1;
#pragma unroll
            for (int j = 0; j < 4; ++j) { o0[j] = siluf_(d0[j] * rstd * g0[j] + b0[j]) * (float)zb[j]; o1[j] = siluf_(d1[j] * rstd * g1[j] + b1[j]) * (float)zb[4 + j]; }
            *(f16x8*)(YC + tok * 1024 + 512 + lane * 8) = cvt8(o0, o1);
        }
        __syncthreads();
    }
}

__device__ __forceinline__ void scan_phase(const Args& a, int G, int bid) {
    int tid = threadIdx.x; asm volatile("" : "+v"(tid));
    const int lane = tid & 63, wave = tid >> 6;
    if (wave != 0) return;
    for (int task = bid; task < 256; task += G) {
        const int g = task >> 3, b = task & 7, n = lane;
        const f32x2 abt = *(const f32x2*)((const float*)(a.ws + WS_ABT) + (size_t)(g * 64 + n) * 2);
        const float* se = (const float*)(a.ws + WS_SEND) + ((size_t)g * 2048 + b * 256) * 128 + 2 * n;
        h16* up = (h16*)(a.ws + WS_UA) + ((size_t)g * 2048 + b * 256) * 384 + 256 + 2 * n;
        float sr = 0.f, si = 0.f;
        for (int k0 = 0; k0 < 256; k0 += 8) {
            f32x2 e[8];
#pragma unroll
            for (int k = 0; k < 8; ++k) e[k] = *(const f32x2*)(se + (size_t)(k0 + k) * 128);
#pragma unroll
            for (int k = 0; k < 8; ++k) {
                f16x2 o; o[0] = (h16)sr; o[1] = (h16)si; *(f16x2*)(up + (size_t)(k0 + k) * 384) = o;
                const float nr = abt[0] * sr - abt[1] * si + e[k][0], ni = abt[0] * si + abt[1] * sr + e[k][1];
                sr = nr; si = ni;
            }
        }
    }
}

constexpr int SEL_CAP = 128;
__device__ __forceinline__ unsigned sortkey(float s) { const unsigned u = __float_as_uint(s); return (u & 0x80000000u) ? ~u : (u | 0x80000000u); }

template <int MODE> __device__ __forceinline__ void idx_pass(const Args& a, LAS unsigned char* lds, int b, int c, const f16x8 (&af)[4][2], const f32x4 (&wr_)[4], int wave, int lane) {
    const h16* KI = (const h16*)(a.ws + WS_KI) + (size_t)b * SEQ * 64;
    LAS unsigned* hist = (LAS unsigned*)lds;
    LAS unsigned short* mask16 = (LAS unsigned short*)lds;
    LAS unsigned long long* cand = (LAS unsigned long long*)(lds + 32768);
    LAS int* sel = (LAS int*)(lds + 131072);
    const int ntile = 4 * (c + 1);
    const int g4 = lane >> 4, odd = g4 & 1;
    const int qa = wave * 8 + (((g4 & 1) << 1) | (g4 >> 1)), qb = qa + 4;
    int bsa = 0, bsb = 0;
    if (MODE == 1) { bsa = sel[qa]; bsb = sel[qb]; }
    for (int tile = 0; tile < ntile; ++tile) {
        const h16* kp = KI + (size_t)(tile * 16 + (lane & 15)) * 64 + 8 * g4;
        const f16x8 b0 = *(const f16x8*)kp, b1 = *(const f16x8*)(kp + 32);
        float part[4];
#pragma unroll
        for (int i = 0; i < 4; ++i) {
            f32x4 d = (f32x4){0.f, 0.f, 0.f, 0.f};
            d = __builtin_amdgcn_mfma_f32_16x16x32_f16(af[i][0], b0, d, 0, 0, 0);
            d = __builtin_amdgcn_mfma_f32_16x16x32_f16(af[i][1], b1, d, 0, 0, 0);
            part[i] = wr_[i][0] * fmaxf(d[0], 0.f) + wr_[i][1] * fmaxf(d[1], 0.f) + wr_[i][2] * fmaxf(d[2], 0.f) + wr_[i][3] * fmaxf(d[3], 0.f);
        }
        const float giveA = odd ? part[0] : part[1], keepA = odd ? part[1] : part[0];
        const float giveB = odd ? part[2] : part[3], keepB = odd ? part[3] : part[2];
        const float sA = (keepA + __shfl_xor(giveA, 16)) + 0.0f, sB = (keepB + __shfl_xor(giveB, 16)) + 0.0f;
        const int key = tile * 16 + (lane & 15);
        int binA = (int)fminf(fmaxf(fmaf(sA, 32.f, 512.f), 0.f), 1023.f), binB = (int)fminf(fmaxf(fmaf(sB, 32.f, 512.f), 0.f), 1023.f);
        if (MODE == 0) {
            atomicAdd((unsigned*)(hist + qa * 512 + (binA >> 1)), (binA & 1) ? 65536u : 1u);
            atomicAdd((unsigned*)(hist + qb * 512 + (binB >> 1)), (binB & 1) ? 65536u : 1u);
        } else {
            const unsigned long long mA = __ballot(binA > bsa), mB = __ballot(binB > bsb);
            if (lane < 4) { const int q = wave * 8 + (((lane & 1) << 1) | (lane >> 1)); mask16[q * 256 + tile] = (unsigned short)(mA >> (16 * lane)); }
            else if (lane < 8) { const int l = lane - 4; const int q = wave * 8 + 4 + (((l & 1) << 1) | (l >> 1)); mask16[q * 256 + tile] = (unsigned short)(mB >> (16 * l)); }
            if (binA == bsa) { const int p = atomicAdd((int*)(sel + 128 + qa), 1); if (p < SEL_CAP) cand[qa * SEL_CAP + p] = ((unsigned long long)sortkey(sA) << 32) | (unsigned)(4095 - key); }
            if (binB == bsb) { const int p = atomicAdd((int*)(sel + 128 + qb), 1); if (p < SEL_CAP) cand[qb * SEL_CAP + p] = ((unsigned long long)sortkey(sB) << 32) | (unsigned)(4095 - key); }
        }
    }
}

__device__ __forceinline__ void idx_phase(const Args& a, LAS unsigned char* lds, int G, int bid) {
    int tid = threadIdx.x; asm volatile("" : "+v"(tid));
    const int lane = tid & 63, wave = tid >> 6;
    unsigned long long* MASK = (unsigned long long*)(a.ws + WS_MASK);
    for (long e = (long)bid * NTHREADS + tid; e < (long)NB * 256 * 4; e += (long)G * NTHREADS) {
        const int w = (int)(e & 3), q = (int)((e >> 2) & 255), b = (int)(e >> 10);
        if (w <= (q >> 6)) MASK[((size_t)b * SEQ + q) * 64 + w] = ~0ull;
    }
    if (bid >= 240) return;
    const int b = bid / 30, j = bid % 30;
    LAS unsigned* hist = (LAS unsigned*)lds;
    LAS int* sel = (LAS int*)(lds + 131072);
    LAS unsigned* mask32 = (LAS unsigned*)lds;
    LAS unsigned long long* cand = (LAS unsigned long long*)(lds + 32768);
    for (int uu = 0; uu < 2; ++uu) {
        const int c = uu == 0 ? 63 - j : 4 + j;
        const size_t tok0 = (size_t)b * SEQ + c * 64;
        f16x8 af[4][2]; f32x4 wr_[4];
        {
            const h16* QI = (const h16*)(a.ws + WS_QI); const float* WI = (const float*)(a.ws + WS_WI);
#pragma unroll
            for (int i = 0; i < 4; ++i) {
                const size_t tq = tok0 + wave * 8 + 2 * i + ((lane & 15) >> 3);
                const h16* p = QI + tq * 512 + (lane & 7) * 64 + 8 * (lane >> 4);
                af[i][0] = *(const f16x8*)p; af[i][1] = *(const f16x8*)(p + 32);
                wr_[i] = *(const f32x4*)(WI + (tok0 + wave * 8 + 2 * i + (lane >> 5)) * 8 + 4 * ((lane >> 4) & 1));
            }
        }
        for (int e = tid; e < 32768; e += NTHREADS) hist[e] = 0u;
        __syncthreads();
        idx_pass<0>(a, lds, b, c, af, wr_, wave, lane);
        __syncthreads();
        for (int ql = 0; ql < 8; ++ql) {
            const int q = wave * 8 + ql;
            unsigned cnt[16]; unsigned s = 0;
#pragma unroll
            for (int k = 0; k < 8; ++k) { const unsigned w = hist[q * 512 + lane * 8 + k]; cnt[2 * k] = w & 0xffffu; cnt[2 * k + 1] = w >> 16; s += cnt[2 * k] + cnt[2 * k + 1]; }
            unsigned suf = s;
#pragma unroll
            for (int o = 1; o < 64; o <<= 1) { const unsigned t = __shfl_down(suf, o); if (lane + o < 64) suf += t; }
            const unsigned above = suf - s;
            if (suf >= 256u && above < 256u) {
                unsigned run = above; int bs = lane * 16; int need = 1;
#pragma unroll
                for (int k = 15; k >= 0; --k) { if (run < 256u && run + cnt[k] >= 256u) { bs = lane * 16 + k; need = 256 - (int)run; } run += cnt[k]; }
                sel[q] = bs; sel[64 + q] = need;
            }
        }
        __syncthreads();
        for (int e = tid; e < 8192; e += NTHREADS) mask32[e] = 0u;
        if (tid < 64) sel[128 + tid] = 0;
        __syncthreads();
        idx_pass<1>(a, lds, b, c, af, wr_, wave, lane);
        __syncthreads();
        for (int ql = 0; ql < 8; ++ql) {
            const int q = wave * 8 + ql; int n = sel[128 + q]; if (n > SEL_CAP) n = SEL_CAP; const int need = sel[64 + q];
            const unsigned long long c0 = lane < n ? cand[q * SEL_CAP + lane] : 0ull, c1 = (lane + 64) < n ? cand[q * SEL_CAP + lane + 64] : 0ull;
            int r0 = 0, r1 = 0;
            for (int i = 0; i < n; ++i) { const unsigned long long ci = cand[q * SEL_CAP + i]; r0 += (ci > c0) ? 1 : 0; r1 += (ci > c1) ? 1 : 0; }
            if (lane < n && r0 < need) { const int key = 4095 - (int)(c0 & 0xfffu); atomicOr((unsigned*)(mask32 + q * 128 + (key >> 5)), 1u << (key & 31)); }
            if (lane + 64 < n && r1 < need) { const int key = 4095 - (int)(c1 & 0xfffu); atomicOr((unsigned*)(mask32 + q * 128 + (key >> 5)), 1u << (key & 31)); }
        }
        __syncthreads();
        for (int e = tid; e < 64 * 64; e += NTHREADS) {
            const int q = e >> 6, w = e & 63;
            if (w <= c) MASK[(tok0 + q) * 64 + w] = (unsigned long long)mask32[q * 128 + 2 * w] | ((unsigned long long)mask32[q * 128 + 2 * w + 1] << 32);
        }
        __syncthreads();
    }
}

__device__ __forceinline__ int crow(int r, int hi) { return (r & 3) + 8 * (r >> 2) + 4 * hi; }
__device__ __forceinline__ void attn_phase(const Args& a, LAS unsigned char* lds, int G, int bid) {
    int tid = threadIdx.x; asm volatile("" : "+v"(tid));
    const int lane = tid & 63, wid = tid >> 6, r32 = lane & 31, hi = lane >> 5;
    const h16* Q = (const h16*)(a.ws + WS_Q); const h16* KB = (const h16*)(a.ws + WS_KB); const h16* VB = (const h16*)(a.ws + WS_VB);
    const h16* ZS = (const h16*)(a.ws + WS_ZS); h16* AO = (h16*)(a.ws + WS_AO);
    const unsigned long long* MASK = (const unsigned long long*)(a.ws + WS_MASK);
    LAS unsigned char* Ks = lds;
    LAS unsigned char* Vs = lds + 8192;
    LAS float* wsf = (LAS float*)(lds + 16384) + wid * 64;
    constexpr float SC = 0.125f * 1.4426950408889634f;
    if (bid >= 256) return;
    const int bg = bid >> 3, s = bid & 7, b = bg >> 2, g = bg & 3;
    for (int ui = 0; ui < 8; ++ui) {
        const int k2 = ui >> 1, base = 16 * k2;
        const int c = (ui & 1) ? base + 15 - s : base + s;
        const size_t tok0 = (size_t)b * SEQ + c * 64;
        const int hh = g * 4 + (wid >> 1), qbase = 32 * (wid & 1);
        const size_t tq = tok0 + qbase + r32;
        f16x8 qr[4];
#pragma unroll
        for (int d0 = 0; d0 < 4; ++d0) qr[d0] = *(const f16x8*)(Q + tq * 1024 + hh * 64 + d0 * 16 + hi * 8);
        f32x16 o0 = {}, o1 = {};
        float mrun = -1e30f, lrun = 0.f;
        const h16* ksrc = KB + ((size_t)b * SEQ + lane) * 256 + g * 64 + wid * 8;
        const h16* vsrc = VB + ((size_t)b * SEQ + 16 * (wid & 3) + (lane >> 2)) * 256 + g * 64 + (wid >> 2) * 32 + (lane & 3) * 8;
        const int nT = c + 1;
        for (int t = 0; t < nT; ++t) {
            const f16x8 kreg = *(const f16x8*)(ksrc + (size_t)t * 64 * 256), vreg = *(const f16x8*)(vsrc + (size_t)t * 64 * 256);
            const unsigned long long mw = MASK[tq * 64 + t];
            __syncthreads();
            *(LAS f16x8*)(Ks + wid * 1024 + lane * 16) = kreg; *(LAS f16x8*)(Vs + wid * 1024 + lane * 16) = vreg;
            __syncthreads();
            f32x16 p0 = {}, p1 = {};
            {
                const LAS unsigned char* kb = Ks + hi * 1024 + r32 * 16;
#pragma unroll
                for (int d0 = 0; d0 < 4; ++d0) {
                    const f16x8 k0 = *(const LAS f16x8*)(kb + d0 * 2048), k1 = *(const LAS f16x8*)(kb + d0 * 2048 + 512);
                    p0 = __builtin_amdgcn_mfma_f32_32x32x16_f16(k0, qr[d0], p0, 0, 0, 0);
                    p1 = __builtin_amdgcn_mfma_f32_32x32x16_f16(k1, qr[d0], p1, 0, 0, 0);
                }
            }
            const unsigned mlo = (unsigned)(mw >> (4 * hi)), mhi = (unsigned)(mw >> (32 + 4 * hi));
            float mx = -INFINITY;
#pragma unroll
            for (int r = 0; r < 16; ++r) {
                const int bit = (r & 3) + 8 * (r >> 2);
                p0[r] = ((mlo >> bit) & 1u) ? p0[r] * SC : -INFINITY;
                p1[r] = ((mhi >> bit) & 1u) ? p1[r] * SC : -INFINITY;
                mx = fmaxf(mx, fmaxf(p0[r], p1[r]));
            }
            mx = fmaxf(mx, __shfl_xor(mx, 32));
            const float mnew = fmaxf(mrun, mx);
            const float alpha = __builtin_amdgcn_exp2f(mrun - mnew);
            mrun = mnew;
            float rs = 0.f;
#pragma unroll
            for (int r = 0; r < 16; ++r) { p0[r] = __builtin_amdgcn_exp2f(p0[r] - mnew); p1[r] = __builtin_amdgcn_exp2f(p1[r] - mnew); rs += p0[r] + p1[r]; }
            lrun = lrun * alpha + rs;
            if (hi == 0) wsf[r32] = alpha;
            f16x8 pa[4];
#pragma unroll
            for (int j = 0; j < 8; ++j) { pa[0][j] = (h16)p0[j]; pa[1][j] = (h16)p0[8 + j]; pa[2][j] = (h16)p1[j]; pa[3][j] = (h16)p1[8 + j]; }
#pragma unroll
            for (int k = 0; k < 4; ++k) { const f32x4 al = *(const LAS f32x4*)(wsf + 8 * k + 4 * hi);
#pragma unroll
                for (int j = 0; j < 4; ++j) { o0[4 * k + j] *= al[j]; o1[4 * k + j] *= al[j]; } }
            {
                const LAS unsigned char* vp = Vs + ((lane >> 4) & 1) * 32 + (lane & 3) * 8 + (4 * hi + ((lane & 15) >> 2)) * 64;
#pragma unroll
                for (int ks = 0; ks < 4; ++ks) {
                    const v4i16_t l0 = __builtin_amdgcn_ds_read_tr16_b64_v4i16((LAS v4i16_t*)(vp + ks * 1024)), h0 = __builtin_amdgcn_ds_read_tr16_b64_v4i16((LAS v4i16_t*)(vp + ks * 1024 + 512));
                    const v4i16_t l1 = __builtin_amdgcn_ds_read_tr16_b64_v4i16((LAS v4i16_t*)(vp + 4096 + ks * 1024)), h1 = __builtin_amdgcn_ds_read_tr16_b64_v4i16((LAS v4i16_t*)(vp + 4096 + ks * 1024 + 512));
                    typedef short s16x8 __attribute__((ext_vector_type(8)));
                    const s16x8 v0 = (s16x8){l0[0], l0[1], l0[2], l0[3], h0[0], h0[1], h0[2], h0[3]}, v1 = (s16x8){l1[0], l1[1], l1[2], l1[3], h1[0], h1[1], h1[2], h1[3]};
                    o0 = __builtin_amdgcn_mfma_f32_32x32x16_f16(pa[ks], __builtin_bit_cast(f16x8, v0), o0, 0, 0, 0);
                    o1 = __builtin_amdgcn_mfma_f32_32x32x16_f16(pa[ks], __builtin_bit_cast(f16x8, v1), o1, 0, 0, 0);
                }
            }
        }
        lrun += __shfl_xor(lrun, 32);
        __syncthreads();
        if (hi == 0) wsf[r32] = 1.0f / lrun;
        const size_t orow0 = tok0 + qbase;
#pragma unroll
        for (int r = 0; r < 16; ++r) {
            const int q = crow(r, hi); const float li = wsf[q];
            const size_t off = (orow0 + q) * 1024 + hh * 64 + r32;
            AO[off] = (h16)(o0[r] * li * (float)ZS[off]);
            AO[off + 32] = (h16)(o1[r] * li * (float)ZS[off + 32]);
        }
        __syncthreads();
    }
}

__device__ __forceinline__ void final_phase(const Args& a, int G, int bid) {
    int tid = threadIdx.x; asm volatile("" : "+v"(tid));
    const int lane = tid & 63, wave = tid >> 6;
    const float* rss = (const float*)(a.ws + WS_RSS2);
    for (int row = bid * 8 + wave; row < MTOK; row += G * 8) {
        const float rs = 1.0f / sqrtf(rss[row] * (1.0f / 1024.0f) + NORM_EPS);
        f32x4* p = (f32x4*)(a.out + (size_t)row * 1024) + lane;
#pragma unroll
        for (int j = 0; j < 4; ++j) { const f32x4 g = *((const f32x4*)a.final_g + lane + 64 * j); p[64 * j] = p[64 * j] * rs * g; }
    }
}

__global__ void __launch_bounds__(NTHREADS, 2) mega(Args a) {
    extern __shared__ __attribute__((aligned(16))) unsigned char lds_raw[];
    LAS unsigned char* lds = (LAS unsigned char*)lds_raw;
    const int G = gridDim.x, bid = blockIdx.x;
    unsigned char* ws = a.ws;
#if ONE_LAUNCH
    cg::grid_group grid = cg::this_grid();
#define SEAM() grid.sync()
#else
#define SEAM() do {} while (0)
#endif
    for (int ph = a.ph_lo; ph < a.ph_hi; ++ph) {
        GemmP g{nullptr, nullptr, 1024, 1024, 1024, 0, 0, MTOK / 256, 4, 0}; int mode = -1;
        if (ph == 1) { g.A = (const char*)(ws + WS_XN); g.Bt = (const char*)(ws + WS_WE_IN); g.nN = NE_IN / 256; mode = E_EVEN_IN; }
        else if (ph == 2) { g = GemmP{(const char*)(ws + WS_UA), (const char*)(ws + WS_MS), 384, 256, 256, 2048L * 384 * 2, 256L * 256 * 2, 8, 1, 32}; mode = E_SEND; }
        else if (ph == 4) { g = GemmP{(const char*)(ws + WS_UA), (const char*)(ws + WS_MY), 384, 384, 384, 2048L * 384 * 2, 256L * 384 * 2, 8, 1, 32}; mode = E_Y; }
        else if (ph == 5) { g = GemmP{(const char*)(ws + WS_GG), (const char*)(ws + WS_WGLU), 512, 512, 512, 0, 0, MTOK / 256, 2, 0}; mode = E_GLU; }
        else if (ph == 6) { g.A = (const char*)(ws + WS_YCAT); g.Bt = (const char*)(ws + WS_WE_OUT); mode = E_OUT_EVEN; }
        else if (ph == 7) { g.A = (const char*)(ws + WS_XN); g.Bt = (const char*)(ws + WS_WO_IN); g.nN = NO_PAD / 256; mode = E_ODD_IN; }
        else if (ph == 10) { g.A = (const char*)(ws + WS_AO); g.Bt = (const char*)(ws + WS_WO_OUT); mode = E_OUT_ODD; }
#ifdef FIXED_MODE
        if (mode >= 0 && ((PH_EN >> ph) & 1)) gemm_phase(lds, g, FIXED_MODE, a, G, bid);
#else
        if (mode >= 0 && ((PH_EN >> ph) & 1)) gemm_phase(lds, g, mode, a, G, bid);
#endif
        if (ph == 0 && (PH_EN & 1)) p0_prologue(a, lds, G, bid);
        else if (ph == 2 && (PH_EN & 4)) { __syncthreads(); conv_phase(a, lds, G, bid); }
        else if (ph == 3 && (PH_EN & 8)) scan_phase(a, G, bid);
        else if (ph == 8 && (PH_EN & 0x100)) idx_phase(a, lds, G, bid);
        else if (ph == 9 && (PH_EN & 0x200)) attn_phase(a, lds, G, bid);
        else if (ph == 11 && (PH_EN & 0x800)) final_phase(a, G, bid);
        if (ph + 1 < a.ph_hi) { SEAM(); }
    }
}

extern "C" void kernel_launch(void* const* d_in, const int* in_sizes, int n_in, void* d_out, int out_size, void* d_ws, size_t ws_size, hipStream_t stream) {
    static int grid = 0;
    if (grid == 0) {
        if (n_in != 21 || out_size != MTOK * DM || ws_size < WS_END) { fprintf(stderr, "kernel_launch: unexpected problem (n_in %d, out %d, ws %zu)\n", n_in, out_size, ws_size); grid = -1; return; }
        if (hipFuncSetAttribute((const void*)mega, hipFuncAttributeMaxDynamicSharedMemorySize, LDS_BYTES) != hipSuccess) { fprintf(stderr, "kernel_launch: hipFuncSetAttribute failed\n"); grid = -1; return; }
        int dev = 0, cus = 0, per_cu = 0;
        (void)hipGetDevice(&dev); (void)hipDeviceGetAttribute(&cus, hipDeviceAttributeMultiprocessorCount, dev);
        (void)hipOccupancyMaxActiveBlocksPerMultiprocessor(&per_cu, (const void*)mega, NTHREADS, LDS_BYTES);
        if (per_cu < 1 || cus != 256) { fprintf(stderr, "kernel_launch: occupancy %d blocks/CU, %d CUs: this kernel needs 1 block on each of 256 CUs\n", per_cu, cus); grid = -1; return; }
        grid = 256;
    }
    if (grid < 0) return;
    (void)hipMemsetAsync((char*)d_ws, 0, CTL_ZERO_BYTES, stream);
    Args a{};
    const float** ap = (const float**)&a;
    for (int i = 0; i < 21; ++i) ap[i] = (const float*)d_in[i];
    a.out = (float*)d_out; a.ws = (unsigned char*)d_ws;
#if ONE_LAUNCH
    a.ph_lo = 0; a.ph_hi = NPHASE;
    void* args[] = {&a};
    hipError_t e = hipLaunchCooperativeKernel((const void*)mega, dim3(grid), dim3(NTHREADS), args, LDS_BYTES, stream);
    if (e != hipSuccess) fprintf(stderr, "cooperative launch failed: %s\n", hipGetErrorString(e));
#else
    for (int ph = 0; ph < NPHASE; ++ph) { a.ph_lo = ph; a.ph_hi = ph + 1; hipLaunchKernelGGL(mega, dim3(grid), dim3(NTHREADS), LDS_BYTES, stream, a); }
#endif
}
```

```cpp
#include <hip/hip_runtime.h>
#include <hip/hip_cooperative_groups.h>
#include <cstdio>
#include <cstdint>
namespace cg = cooperative_groups;

#define LAS __attribute__((address_space(3)))
typedef _Float16 h16;
typedef _Float16 f16x8 __attribute__((ext_vector_type(8)));
typedef _Float16 f16x4 __attribute__((ext_vector_type(4)));
typedef _Float16 f16x2 __attribute__((ext_vector_type(2)));
typedef float f32x2 __attribute__((ext_vector_type(2)));
typedef float f32x4 __attribute__((ext_vector_type(4)));
typedef float f32x16 __attribute__((ext_vector_type(16)));
typedef unsigned u32x4 __attribute__((ext_vector_type(4)));
typedef short v4i16_t __attribute__((ext_vector_type(4)));

#ifndef PH_EN
#define PH_EN 0xFFF
#endif
#ifndef PH_REP
#define PH_REP 0
#endif
#ifndef ONE_LAUNCH
#define ONE_LAUNCH 1
#endif

constexpr int NB = 8, SEQ = 4096, DM = 1024, MTOK = NB * SEQ;
constexpr int NE_IN = 2560, NO_IN = 3144, NO_PAD = 3328;
constexpr float NORM_EPS = 1e-6f;
constexpr int NTHREADS = 512;
constexpr int LDS_BYTES = 163840;
constexpr int NPHASE = 12;

constexpr size_t MiB = 1u << 20;
constexpr size_t WS_RSS1 = 0, WS_RSS2 = 128 * 1024, WS_BAR = 256 * 1024, CTL_ZERO_BYTES = 256 * 1024 + 16 * 1024;
constexpr size_t WS_ROPE = 1 * MiB;
constexpr size_t WS_ABT = 1 * MiB + 512 * 1024;
constexpr size_t WS_WE_IN = 2 * MiB;
constexpr size_t WS_WGLU = 7 * MiB;
constexpr size_t WS_WE_OUT = 8 * MiB;
constexpr size_t WS_WO_IN = 10 * MiB;
constexpr size_t WS_WO_OUT = 17 * MiB;
constexpr size_t WS_MY = 19 * MiB;
constexpr size_t WS_MS = 25 * MiB;
constexpr size_t WS_S5T = 29 * MiB;
constexpr size_t WS_XN = 32 * MiB;
constexpr size_t WS_UA = 96 * MiB;
constexpr size_t WS_SEND = 144 * MiB;
constexpr size_t WS_ZA = 176 * MiB;
constexpr size_t WS_HB = 208 * MiB;
constexpr size_t WS_ZB = 240 * MiB;
constexpr size_t WS_GG = 272 * MiB;
constexpr size_t WS_YCAT = 304 * MiB;
constexpr size_t WS_Q = 96 * MiB;
constexpr size_t WS_ZS = 160 * MiB;
constexpr size_t WS_KB = 224 * MiB;
constexpr size_t WS_VB = 240 * MiB;
constexpr size_t WS_QI = 256 * MiB;
constexpr size_t WS_KI = 288 * MiB;
constexpr size_t WS_WI = 292 * MiB;
constexpr size_t WS_MASK = 296 * MiB;
constexpr size_t WS_AO = 312 * MiB;
constexpr size_t WS_END = 376 * MiB;

struct Args {
    const float* x; const float* norm_g; const float* e_w_in; const float* e_lam_re; const float* e_lam_im; const float* e_log_step;
    const float* e_b_re; const float* e_b_im; const float* e_c_re; const float* e_c_im; const float* e_d_skip; const float* e_w_glu; const float* e_b_glu;
    const float* e_conv_w; const float* e_conv_b; const float* e_ln_g; const float* e_ln_b; const float* e_w_out; const float* o_w_in; const float* o_w_out; const float* final_g;
    float* out; unsigned char* ws; int ph_lo, ph_hi;
};

__device__ __forceinline__ float wave_sum(float v) {
#pragma unroll
    for (int o = 1; o < 64; o <<= 1) v += __shfl_xor(v, o);
    return v;
}
__device__ __forceinline__ float sigmoidf_(float x) { return 1.0f / (1.0f + __expf(-x)); }
__device__ __forceinline__ float siluf_(float x) { return x / (1.0f + __expf(-x)); }
__device__ __forceinline__ float gelu_tanh(float x) {
    const float u = 0.7978845608028654f * (x + 0.044715f * x * x * x);
    const float e = __expf(2.0f * u);
    const float t = 1.0f - 2.0f / (e + 1.0f);
    return 0.5f * x * (1.0f + t);
}
__device__ __forceinline__ f16x8 cvt8(const f32x4 a, const f32x4 b) {
    f16x8 o; o[0] = (h16)a[0]; o[1] = (h16)a[1]; o[2] = (h16)a[2]; o[3] = (h16)a[3]; o[4] = (h16)b[0]; o[5] = (h16)b[1]; o[6] = (h16)b[2]; o[7] = (h16)b[3]; return o;
}

constexpr int BM = 256, BK = 64, HALF = 128, HTB = HALF * BK * 2, STAGE_BYTES = 8 * HTB;
__device__ __forceinline__ int lds_byte(int r, int c) { const int st = (r >> 4) * 2 + (c >> 5), rr = r & 15, cc = c & 31, ob = rr * 64 + cc * 2; return st * 1024 + (ob ^ (((ob >> 9) & 1) << 5)); }
__device__ __forceinline__ void stage_rc(int b, int& R, int& C) { const int st = b / 1024, sb = b % 1024, swz = sb ^ (((sb >> 9) & 1) << 5); R = (st >> 1) * 16 + swz / 64; C = (st & 1) * 32 + (swz % 64) / 2; }
__device__ __forceinline__ int perm32(int rho) { const int n = rho >> 4, i = rho & 15; return 8 * (i >> 2) + 4 * n + (i & 3); }

struct Unit { int pm, pn, grp; };
struct GemmP { const char* A; const char* Bt; int lda, ldb, K; long gsA, gsB; int nM, nN, ngrp; };

__device__ __forceinline__ bool unit_next(const GemmP& g, int i, int G, int c, Unit& u) {
    const long Lx = (long)i * G + c;
    const bool grouped = g.ngrp > 0;
    const int nwg = grouped ? g.nM * g.ngrp : g.nM * g.nN;
    const bool ok = Lx < (long)nwg;
    const int L0 = ok ? (int)Lx : 0;
    const int gpm = L0 % g.nM, ggrp = L0 / g.nM;
    int wgid = L0; { const int q = nwg / 8, r = nwg % 8, xcd = wgid % 8, off = wgid / 8; wgid = (xcd < r ? xcd * (q + 1) : r * (q + 1) + (xcd - r) * q) + off; }
    const int nig = 8 * g.nN, gid = wgid / nig, fm = gid * 8, gsz = (g.nM - fm) < 8 ? (g.nM - fm) : 8;
    const int dpm = fm + ((wgid % nig) % gsz), dpn = (wgid % nig) / gsz;
    Unit r; r.pm = grouped ? gpm : dpm; r.pn = grouped ? 0 : dpn; r.grp = grouped ? ggrp : 0;
    u = r; return ok;
}

enum EpiMode { E_EVEN_IN = 0, E_SEND = 1, E_Y = 2, E_GLU = 3, E_OUT_EVEN = 4, E_ODD_IN = 5, E_OUT_ODD = 6 };

__device__ __forceinline__ void epilogue(const int mode, const Args& a, const f32x4 (&acc)[2][2][4][2], const Unit& u, int wr, int wc, int fr, int fq) {
    asm volatile("" : "+v"(fr), "+v"(fq));
    unsigned char* ws = a.ws;
    const int colw = 32 * wc + 8 * fq;
    if (mode == E_EVEN_IN) {
        const int pn = u.pn;
        if (pn >= 4 && pn < 8) {
            h16* HB = (h16*)(ws + WS_HB);
#pragma unroll
            for (int ai = 0; ai < 2; ++ai)
#pragma unroll
                for (int m = 0; m < 4; ++m) {
                    const int row = u.pm * BM + ai * HALF + wr * 64 + m * 16 + fr;
                    f32x4 o0, o1;
#pragma unroll
                    for (int j = 0; j < 4; ++j) { o0[j] = acc[ai][0][m][0][j] * sigmoidf_(acc[ai][1][m][0][j]); o1[j] = acc[ai][0][m][1][j] * sigmoidf_(acc[ai][1][m][1][j]); }
                    *(f16x8*)(HB + (size_t)row * 512 + (pn - 4) * 128 + colw) = cvt8(o0, o1);
                }
        } else {
#pragma unroll
            for (int ai = 0; ai < 2; ++ai)
#pragma unroll
                for (int m = 0; m < 4; ++m) {
                    const int row = u.pm * BM + ai * HALF + wr * 64 + m * 16 + fr;
#pragma unroll
                    for (int bj = 0; bj < 2; ++bj) {
                        const int col = pn * BM + bj * HALF + colw;
                        f32x4 v0 = acc[ai][bj][m][0], v1 = acc[ai][bj][m][1];
                        if (pn < 2) {
                            const int g = col >> 4;
                            h16* p = (h16*)(ws + WS_UA) + (size_t)g * (2048 * 384) + (size_t)(row >> 4) * 384 + (row & 15) * 16 + (col & 15);
                            *(f16x8*)p = cvt8(v0, v1);
                        } else {
#pragma unroll
                            for (int j = 0; j < 4; ++j) { v0[j] = siluf_(v0[j]); v1[j] = siluf_(v1[j]); }
                            if (pn < 4) *(f16x8*)((h16*)(ws + WS_ZA) + (size_t)row * 512 + (col - 512)) = cvt8(v0, v1);
                            else        *(f16x8*)((h16*)(ws + WS_ZB) + (size_t)row * 512 + (col - 2048)) = cvt8(v0, v1);
                        }
                    }
                }
        }
    } else if (mode == E_SEND) {
        float* SE = (float*)(ws + WS_SEND) + (size_t)u.grp * (2048 * 128);
#pragma unroll
        for (int ai = 0; ai < 2; ++ai)
#pragma unroll
            for (int m = 0; m < 4; ++m) {
                const int row = u.pm * BM + ai * HALF + wr * 64 + m * 16 + fr;
                float* p = SE + (size_t)row * 128 + colw;
                *(f32x4*)p = acc[ai][0][m][0]; *(f32x4*)(p + 4) = acc[ai][0][m][1];
            }
    } else if (mode == E_Y) {
        const h16* UA = (const h16*)(ws + WS_UA) + (size_t)u.grp * (2048 * 384);
        h16* GG = (h16*)(ws + WS_GG);
#pragma unroll
        for (int bj = 0; bj < 2; ++bj) {
            const int col = bj * HALF + colw, t = col >> 4, c0 = col & 15;
            const f32x4 d0 = *(const f32x4*)(a.e_d_skip + u.grp * 16 + c0), d1 = *(const f32x4*)(a.e_d_skip + u.grp * 16 + c0 + 4);
#pragma unroll
            for (int ai = 0; ai < 2; ++ai)
#pragma unroll
                for (int m = 0; m < 4; ++m) {
                    const int row = u.pm * BM + ai * HALF + wr * 64 + m * 16 + fr;
                    const f16x8 uu = *(const f16x8*)(UA + (size_t)row * 384 + col);
                    f32x4 o0, o1;
#pragma unroll
                    for (int j = 0; j < 4; ++j) { o0[j] = gelu_tanh(acc[ai][bj][m][0][j] + (float)uu[j] * d0[j]); o1[j] = gelu_tanh(acc[ai][bj][m][1][j] + (float)uu[4 + j] * d1[j]); }
                    *(f16x8*)(GG + ((size_t)row * 16 + t) * 512 + u.grp * 16 + c0) = cvt8(o0, o1);
                }
        }
    } else if (mode == E_GLU) {
        const h16* GG = (const h16*)(ws + WS_GG); const h16* ZA = (const h16*)(ws + WS_ZA); h16* YC = (h16*)(ws + WS_YCAT);
#pragma unroll
        for (int bj = 0; bj < 2; ++bj) {
            const int col = u.pn * BM + bj * HALF + colw;
            const f32x4 b0 = *(const f32x4*)(a.e_b_glu + col), b1 = *(const f32x4*)(a.e_b_glu + col + 4);
#pragma unroll
            for (int ai = 0; ai < 2; ++ai)
#pragma unroll
                for (int m = 0; m < 4; ++m) {
                    const int row = u.pm * BM + ai * HALF + wr * 64 + m * 16 + fr;
                    const f16x8 gg = *(const f16x8*)(GG + (size_t)row * 512 + col), za = *(const f16x8*)(ZA + (size_t)row * 512 + col);
                    f32x4 o0, o1;
#pragma unroll
                    for (int j = 0; j < 4; ++j) { o0[j] = (float)gg[j] * sigmoidf_(acc[ai][bj][m][0][j] + b0[j]) * (float)za[j]; o1[j] = (float)gg[4 + j] * sigmoidf_(acc[ai][bj][m][1][j] + b1[j]) * (float)za[4 + j]; }
                    *(f16x8*)(YC + (size_t)row * 1024 + col) = cvt8(o0, o1);
                }
        }
    } else if (mode == E_OUT_EVEN || mode == E_OUT_ODD) {
        const float* base = (mode == E_OUT_EVEN) ? a.x : a.out;
        float* rss = (float*)(ws + (mode == E_OUT_EVEN ? WS_RSS1 : WS_RSS2));
        h16* H1 = (h16*)(ws + WS_XN);
#pragma unroll
        for (int ai = 0; ai < 2; ++ai)
#pragma unroll
            for (int m = 0; m < 4; ++m) {
                const int row = u.pm * BM + ai * HALF + wr * 64 + m * 16 + fr;
                float ss = 0.f;
#pragma unroll
                for (int bj = 0; bj < 2; ++bj) {
                    const int col = u.pn * BM + bj * HALF + colw;
                    const size_t off = (size_t)row * 1024 + col;
                    const f32x4 x0 = *(const f32x4*)(base + off), x1 = *(const f32x4*)(base + off + 4);
                    const f32x4 h0 = x0 + acc[ai][bj][m][0], h1 = x1 + acc[ai][bj][m][1];
                    *(f32x4*)(a.out + off) = h0; *(f32x4*)(a.out + off + 4) = h1;
                    if (mode == E_OUT_EVEN) *(f16x8*)(H1 + off) = cvt8(h0, h1);
#pragma unroll
                    for (int j = 0; j < 4; ++j) ss += h0[j] * h0[j] + h1[j] * h1[j];
                }
                ss += __shfl_xor(ss, 16); ss += __shfl_xor(ss, 32);
                if (fq == 0) atomicAdd(rss + row, ss);
            }
    } else if (mode == E_ODD_IN) {
        const int pn = u.pn;
        const float* rss = (const float*)(ws + WS_RSS1);
        const float* ROPE = (const float*)(ws + WS_ROPE);
#pragma unroll
        for (int ai = 0; ai < 2; ++ai)
#pragma unroll
            for (int m = 0; m < 4; ++m) {
                const int row = u.pm * BM + ai * HALF + wr * 64 + m * 16 + fr;
                const float rs = 1.0f / sqrtf(rss[row] * (1.0f / 1024.0f) + NORM_EPS);
                const int pos = row & (SEQ - 1);
#pragma unroll
                for (int bj = 0; bj < 2; ++bj) {
                    const int col = pn * BM + bj * HALF + colw;
                    f32x4 v0 = acc[ai][bj][m][0] * rs, v1 = acc[ai][bj][m][1] * rs;
                    const bool ropeT = (pn < 4) || pn == 8 || pn == 10 || pn == 11 || (pn == 12 && col < 3072 + 64);
                    if (ropeT && (col & 63) < 16) {
                        const int i0 = (col & 63) >> 1;
                        const f32x4 cs0 = *(const f32x4*)(ROPE + pos * 16 + i0 * 2), cs1 = *(const f32x4*)(ROPE + pos * 16 + i0 * 2 + 4);
                        f32x4 r0, r1;
                        r0[0] = v0[0] * cs0[0] - v0[1] * cs0[1]; r0[1] = v0[0] * cs0[1] + v0[1] * cs0[0];
                        r0[2] = v0[2] * cs0[2] - v0[3] * cs0[3]; r0[3] = v0[2] * cs0[3] + v0[3] * cs0[2];
                        r1[0] = v1[0] * cs1[0] - v1[1] * cs1[1]; r1[1] = v1[0] * cs1[1] + v1[1] * cs1[0];
                        r1[2] = v1[2] * cs1[2] - v1[3] * cs1[3]; r1[3] = v1[2] * cs1[3] + v1[3] * cs1[2];
                        v0 = r0; v1 = r1;
                    }
                    if (pn < 4) *(f16x8*)((h16*)(ws + WS_Q) + (size_t)row * 1024 + col) = cvt8(v0 * 0.18033688011112042f, v1 * 0.18033688011112042f);
                    else if (pn < 8) {
#pragma unroll
                        for (int j = 0; j < 4; ++j) { v0[j] = siluf_(v0[j]); v1[j] = siluf_(v1[j]); }
                        *(f16x8*)((h16*)(ws + WS_ZS) + (size_t)row * 1024 + (col - 1024)) = cvt8(v0, v1);
                    } else if (pn == 8) *(f16x8*)((h16*)(ws + WS_KB) + (size_t)row * 256 + (col - 2048)) = cvt8(v0, v1);
                    else if (pn == 9) *(f16x8*)((h16*)(ws + WS_VB) + (size_t)row * 256 + (col - 2304)) = cvt8(v0, v1);
                    else if (pn < 12) *(f16x8*)((h16*)(ws + WS_QI) + (size_t)row * 512 + (col - 2560)) = cvt8(v0, v1);
                    else {
                        const int cl = col - 3072;
                        if (cl < 64) *(f16x8*)((h16*)(ws + WS_KI) + (size_t)row * 64 + cl) = cvt8(v0, v1);
                        else if (cl == 64) { float* w = (float*)(ws + WS_WI) + (size_t)row * 8; *(f32x4*)w = v0 * 0.04419417382415922f; *(f32x4*)(w + 4) = v1 * 0.04419417382415922f; }
                    }
                }
            }
    }
}

__device__ __forceinline__ void gemm_phase(LAS unsigned char* lds, const GemmP g, const int mode, const Args& a, const int G, const int c) {
    int tid = threadIdx.x; asm volatile("" : "+v"(tid));
    const int wid = __builtin_amdgcn_readfirstlane(tid >> 6), lane = tid & 63, wr = wid >> 2, wc = wid & 3, fr = lane & 15, fq = lane >> 4;
    const int nt = g.K / BK;
    unsigned voffA[2], voffB[2];
#pragma unroll
    for (int i = 0; i < 2; ++i) { int R, C; stage_rc(tid * 16 + i * 8192, R, C); const int Rb = (R & ~31) + perm32(R & 31);
        voffA[i] = (unsigned)(R * g.lda + C) * 2u; voffB[i] = (unsigned)(Rb * g.ldb + C) * 2u; }
    const size_t kstep = (size_t)(BK * 2);
    const size_t hstepA = (size_t)HALF * g.lda * 2, hstepB = (size_t)HALF * g.ldb * 2;
    const unsigned ldsw = (unsigned)wid * 1024u;
    const int aoff = lds_byte(wr * 64 + fr, fq * 8), boff = lds_byte(wc * 32 + fr, fq * 8);
#define PG8_SA(b, h) (((b) * 2 + (h)) * HTB)
#define PG8_SB(b, h) ((4 + (b) * 2 + (h)) * HTB)
#define PG8_STAGE(bufoff, gbase, voff) do { _Pragma("unroll") for (int _i = 0; _i < 2; ++_i) \
        __builtin_amdgcn_global_load_lds((const unsigned*)((const char*)(gbase) + (voff)[_i]), (LAS unsigned*)(lds + (bufoff) + ldsw + _i * 8192), 16, 0, 0); } while (0)
#define PG8_LDA(dst, b, h) do { _Pragma("unroll") for (int m = 0; m < 4; ++m) _Pragma("unroll") for (int k = 0; k < 2; ++k) dst[m][k] = *(const LAS f16x8*)(lds + PG8_SA(b, h) + aoff + m * 2048 + k * 1024); } while (0)
#define PG8_LDB(dst, b, h) do { _Pragma("unroll") for (int n = 0; n < 2; ++n) _Pragma("unroll") for (int k = 0; k < 2; ++k) dst[n][k] = *(const LAS f16x8*)(lds + PG8_SB(b, h) + boff + n * 2048 + k * 1024); } while (0)
#define PG8_MMA(ai, bj, At, Bt) do { __builtin_amdgcn_s_setprio(1); _Pragma("unroll") for (int m = 0; m < 4; ++m) _Pragma("unroll") for (int n = 0; n < 2; ++n) _Pragma("unroll") for (int k = 0; k < 2; ++k) \
        acc[ai][bj][m][n] = __builtin_amdgcn_mfma_f32_16x16x32_f16(Bt[n][k], At[m][k], acc[ai][bj][m][n], 0, 0, 0); __builtin_amdgcn_s_setprio(0); } while (0)
#define PG8_WAIT_V(n) asm volatile("s_waitcnt vmcnt(" #n ")" ::: "memory")
#define PG8_WAIT_L(n) asm volatile("s_waitcnt lgkmcnt(" #n ")" ::: "memory")
#define PG8_BAR __builtin_amdgcn_s_barrier()
#define PG8_SCHED __builtin_amdgcn_sched_barrier(0)
    Unit cur, nxt; int ui = 0;
    if (!unit_next(g, 0, G, c, cur)) return;
    f32x4 acc[2][2][4][2];
#pragma unroll
    for (int a_ = 0; a_ < 2; ++a_)
#pragma unroll
        for (int b = 0; b < 2; ++b)
#pragma unroll
            for (int m = 0; m < 4; ++m)
#pragma unroll
                for (int n = 0; n < 2; ++n) acc[a_][b][m][n] = (f32x4){0.f, 0.f, 0.f, 0.f};
    f16x8 At[4][2], B0[2][2], B1[2][2];
    const char* cA = g.A + (size_t)cur.grp * g.gsA + (size_t)cur.pm * 2 * hstepA; const char* cB = g.Bt + (size_t)cur.grp * g.gsB + (size_t)cur.pn * 2 * hstepB;
    PG8_STAGE(PG8_SB(0, 0), cB, voffB); PG8_STAGE(PG8_SB(0, 1), cB + hstepB, voffB); PG8_STAGE(PG8_SA(0, 0), cA, voffA); PG8_STAGE(PG8_SA(0, 1), cA + hstepA, voffA);
    if (wr == 1) PG8_BAR;
    PG8_WAIT_V(2); PG8_BAR;
    PG8_STAGE(PG8_SB(1, 0), cB + kstep, voffB); PG8_STAGE(PG8_SA(1, 0), cA + kstep, voffA); PG8_STAGE(PG8_SB(1, 1), cB + hstepB + kstep, voffB);
    PG8_WAIT_V(6); PG8_BAR;
    for (;;) {
        const bool has_next = unit_next(g, ui + 1, G, c, nxt);
        const char* nA = has_next ? g.A + (size_t)nxt.grp * g.gsA + (size_t)nxt.pm * 2 * hstepA : cA; const char* nB = has_next ? g.Bt + (size_t)nxt.grp * g.gsB + (size_t)nxt.pn * 2 * hstepB : cB;
        for (int t = 0; t < nt; t += 2) {
            const bool last = (t == nt - 2);
            const char* a1 = cA + (size_t)(t + 1) * kstep;
            const char* a2 = last ? nA : cA + (size_t)(t + 2) * kstep; const char* b2 = last ? nB : cB + (size_t)(t + 2) * kstep;
            const char* a3 = a2 + kstep; const char* b3 = b2 + kstep;
            PG8_LDB(B0, 0, 0); PG8_LDB(B1, 0, 1); PG8_SCHED; PG8_LDA(At, 0, 0); PG8_STAGE(PG8_SA(1, 1), a1 + hstepA, voffA);
            PG8_WAIT_V(8); PG8_WAIT_L(0); PG8_BAR; PG8_MMA(0, 0, At, B0); PG8_MMA(0, 1, At, B1); PG8_BAR; PG8_SCHED;
            PG8_LDA(At, 0, 1); PG8_STAGE(PG8_SB(0, 0), b2, voffB); PG8_STAGE(PG8_SB(0, 1), b2 + hstepB, voffB); PG8_STAGE(PG8_SA(0, 0), a2, voffA);
            PG8_WAIT_V(8); PG8_WAIT_L(0); PG8_BAR; PG8_MMA(1, 0, At, B0); PG8_MMA(1, 1, At, B1); PG8_BAR; PG8_SCHED;
            PG8_LDB(B0, 1, 0); PG8_LDB(B1, 1, 1); PG8_SCHED; PG8_LDA(At, 1, 0); PG8_STAGE(PG8_SA(0, 1), a2 + hstepA, voffA);
            PG8_WAIT_V(8); PG8_WAIT_L(0); PG8_BAR; PG8_MMA(0, 0, At, B0); PG8_MMA(0, 1, At, B1); PG8_BAR; PG8_SCHED;
            PG8_LDA(At, 1, 1); PG8_STAGE(PG8_SB(1, 0), b3, voffB); PG8_STAGE(PG8_SB(1, 1), b3 + hstepB, voffB); PG8_STAGE(PG8_SA(1, 0), a3, voffA);
            PG8_WAIT_V(8); PG8_WAIT_L(0); PG8_BAR; PG8_MMA(1, 0, At, B0); PG8_MMA(1, 1, At, B1); PG8_BAR; PG8_SCHED;
        }
        if (wr == 0) PG8_BAR;
        epilogue(mode, a, acc, cur, wr, wc, fr, fq);
        if (!has_next) break;
#pragma unroll
        for (int a_ = 0; a_ < 2; ++a_)
#pragma unroll
            for (int b = 0; b < 2; ++b)
#pragma unroll
                for (int m = 0; m < 4; ++m)
#pragma unroll
                    for (int n = 0; n < 2; ++n) acc[a_][b][m][n] = (f32x4){0.f, 0.f, 0.f, 0.f};
        cur = nxt; cA = nA; cB = nB; ++ui;
        if (wr == 1) PG8_BAR;
    }
    PG8_WAIT_V(0);
    PG8_BAR;
#undef PG8_SA
#undef PG8_SB
#undef PG8_STAGE
#undef PG8_LDA
#undef PG8_LDB
#undef PG8_MMA
#undef PG8_WAIT_V
#undef PG8_WAIT_L
#undef PG8_BAR
#undef PG8_SCHED
}

__device__ __forceinline__ int src_col_e_in(int n) { if (n < 1024 || n >= 2048) return n; const int j = (n - 1024) >> 8, w = (n - 1024) & 255; return w < 128 ? 1024 + 128 * j + w : 1536 + 128 * j + (w - 128); }
__device__ __forceinline__ int rot_dim(int p) { return p < 16 ? ((p & 1) ? 8 + (p >> 1) : (p >> 1)) : p; }
__device__ __forceinline__ int src_col_o_in(int n) {
    if (n < 1024) return (n & ~63) + rot_dim(n & 63);
    if (n < 2048) return n;
    if (n < 2304) return (n & ~63) + rot_dim(n & 63);
    if (n < 2560) return n;
    if (n < 3136) return (n & ~63) + rot_dim(n & 63);
    if (n < NO_IN) return n;
    return -1;
}
template <int MAP> __device__ __forceinline__ void conv_w(const float* src, int K, int Nsrc, h16* dst, int Nout, const float* kscale, LAS float* scr, int item, int lane) {
    const int nblk = Nout / 32, kb = item / nblk, nb = item % nblk, k0 = 64 * kb, n0 = 32 * nb;
    const int m0 = (MAP == 1) ? src_col_e_in(n0) : (MAP == 2) ? src_col_o_in(n0) : n0;
    const int sb = m0 & ~31, sc = sb + (lane & 31);
#pragma unroll 8
    for (int i = 0; i < 32; ++i) { const int kk = 2 * i + (lane >> 5); scr[kk * 33 + (lane & 31)] = (sc >= 0 && sc < Nsrc) ? src[(size_t)(k0 + kk) * Nsrc + sc] : 0.f; }
    asm volatile("s_waitcnt lgkmcnt(0)" ::: "memory");
    const int cch = lane & 7;
    f32x4 ks0 = (f32x4){1.f, 1.f, 1.f, 1.f}, ks1 = ks0;
    if (kscale) { ks0 = *(const f32x4*)(kscale + k0 + 8 * cch); ks1 = *(const f32x4*)(kscale + k0 + 8 * cch + 4); }
#pragma unroll
    for (int j = 0; j < 4; ++j) {
        const int n = n0 + (lane >> 3) + 8 * j;
        const int m = (MAP == 1) ? src_col_e_in(n) : (MAP == 2) ? src_col_o_in(n) : n;
        f16x8 o = (f16x8){};
        if (m >= 0) { const LAS float* p = scr + (8 * cch) * 33 + (m - sb);
            o[0] = (h16)(p[0] * ks0[0]); o[1] = (h16)(p[33] * ks0[1]); o[2] = (h16)(p[66] * ks0[2]); o[3] = (h16)(p[99] * ks0[3]);
            o[4] = (h16)(p[132] * ks1[0]); o[5] = (h16)(p[165] * ks1[1]); o[6] = (h16)(p[198] * ks1[2]); o[7] = (h16)(p[231] * ks1[3]); }
        *(f16x8*)(dst + (size_t)n * K + k0 + 8 * cch) = o;
    }
    asm volatile("s_waitcnt lgkmcnt(0)" ::: "memory");
}

constexpr int S5T_PWR = 0, S5T_PWI = 1088, S5T_BBR = 2176, S5T_BBI = 3200, S5T_CR = 4224, S5T_CI = 5248, S5T_KT = 6272, S5T_STRIDE = 10368;
__device__ __forceinline__ void s5_tables(const Args& a, LAS unsigned char* lds, int g, int part) {
    LAS float* F = (LAS float*)lds;
    LAS float* PWr = F, *PWi = F + 1088, *KKr = F + 2176, *KKi = F + 2240, *BBr = F + 2304, *BBi = F + 3328, *Cr = F + 4352, *Ci = F + 5376;
    float* T = (float*)(a.ws + WS_S5T) + (size_t)g * S5T_STRIDE;
    int tid = threadIdx.x; asm volatile("" : "+v"(tid));
    const float dt = expf(a.e_log_step[g]);
    for (int e = tid; e < 1088; e += NTHREADS) {
        const int n = e / 17, j = e % 17;
        const float lr = fminf(a.e_lam_re[g * 64 + n], -1e-4f), li = a.e_lam_im[g * 64 + n];
        const float mag = expf((float)j * (lr * dt)); float s, c; sincosf((float)j * (li * dt), &s, &c);
        PWr[e] = mag * c; PWi[e] = mag * s;
    }
    if (tid < 64) {
        const int n = tid;
        const float lr = fminf(a.e_lam_re[g * 64 + n], -1e-4f), li = a.e_lam_im[g * 64 + n];
        float s, c, sh, ch; sincosf(li * dt, &s, &c); sincosf(0.5f * li * dt, &sh, &ch);
        const float em1 = expm1f(lr * dt);
        const float nr = em1 * c - 2.0f * sh * sh, ni = (em1 + 1.0f) * s, den = lr * lr + li * li;
        KKr[n] = (nr * lr + ni * li) / den; KKi[n] = (ni * lr - nr * li) / den;
        if (part == 0) { const float m16 = expf(16.0f * (lr * dt)); float s16, c16; sincosf(16.0f * (li * dt), &s16, &c16);
            float* abt = (float*)(a.ws + WS_ABT) + (size_t)(g * 64 + n) * 2; abt[0] = m16 * c16; abt[1] = m16 * s16; }
    }
    __syncthreads();
    for (int e = tid; e < 1024; e += NTHREADS) {
        { const int n = e >> 4, cc = e & 15; const float br = a.e_b_re[(size_t)(g * 64 + n) * 16 + cc], bi = a.e_b_im[(size_t)(g * 64 + n) * 16 + cc];
          BBr[e] = KKr[n] * br - KKi[n] * bi; BBi[e] = KKr[n] * bi + KKi[n] * br; }
        { const int cc = e >> 6, n = e & 63; Cr[e] = a.e_c_re[(size_t)(g * 16 + cc) * 64 + n]; Ci[e] = a.e_c_im[(size_t)(g * 16 + cc) * 64 + n]; }
    }
    __syncthreads();
    {
        const int e = part * 512 + tid, tau = e >> 8, cc = (e >> 4) & 15, cp = e & 15; float s = 0.f;
        for (int n = 0; n < 64; ++n) {
            const float cr = Cr[cc * 64 + n], ci = Ci[cc * 64 + n], pr = PWr[n * 17 + tau], pi = PWi[n * 17 + tau];
            const float tr = cr * pr - ci * pi, ti = cr * pi + ci * pr;
            s += tr * BBr[n * 16 + cp] - ti * BBi[n * 16 + cp];
        }
        T[S5T_KT + e] = s;
    }
    if (part == 0) { for (int e = tid; e < 6272; e += NTHREADS) T[e] = (e < 2176) ? F[e] : F[e + 128]; }
    __syncthreads();
}
__device__ __forceinline__ void s5_fill(const Args& a, int G, int bid) {
    int tid = threadIdx.x; asm volatile("" : "+v"(tid));
    const float* TB = (const float*)(a.ws + WS_S5T);
    for (int e = bid * NTHREADS + tid; e < 32 * 256 * 48; e += G * NTHREADS) {
        const int g = e / (256 * 48), r = e % (256 * 48), row = r / 48, cg = r % 48, t = row >> 4, cc = row & 15; const float* T = TB + (size_t)g * S5T_STRIDE; f16x8 o;
#pragma unroll
        for (int j = 0; j < 8; ++j) {
            const int col = cg * 8 + j; float v;
            if (col < 256) { const int tp = col >> 4, cp = col & 15; v = (t >= tp) ? T[S5T_KT + (t - tp) * 256 + cc * 16 + cp] : 0.f; }
            else { const int q = col - 256, n = q >> 1, ri = q & 1; const float cr = T[S5T_CR + cc * 64 + n], ci = T[S5T_CI + cc * 64 + n], pr = T[S5T_PWR + n * 17 + t + 1], pi = T[S5T_PWI + n * 17 + t + 1];
                   v = ri == 0 ? (cr * pr - ci * pi) : -(cr * pi + ci * pr); }
            o[j] = (h16)v;
        }
        *(f16x8*)((h16*)(a.ws + WS_MY) + (size_t)g * (256 * 384) + (size_t)row * 384 + cg * 8) = o;
    }
    for (int e = bid * NTHREADS + tid; e < 32 * 256 * 32; e += G * NTHREADS) {
        const int g = e >> 13, r = e & 8191, row = r >> 5, cg = r & 31; const float* T = TB + (size_t)g * S5T_STRIDE; f16x8 o;
#pragma unroll
        for (int j = 0; j < 8; ++j) {
            float v = 0.f;
            if (row < 128) { const int n = row >> 1, ri = row & 1, col = cg * 8 + j, tp = col >> 4, cp = col & 15;
                const float pr = T[S5T_PWR + n * 17 + 15 - tp], pi = T[S5T_PWI + n * 17 + 15 - tp], br = T[S5T_BBR + n * 16 + cp], bi = T[S5T_BBI + n * 16 + cp];
                v = ri == 0 ? (pr * br - pi * bi) : (pr * bi + pi * br); }
            o[j] = (h16)v;
        }
        *(f16x8*)((h16*)(a.ws + WS_MS) + (size_t)g * (256 * 256) + (size_t)row * 256 + cg * 8) = o;
    }
}

__device__ __forceinline__ void p0_prologue(const Args& a, LAS unsigned char* lds, int G, int bid) {
    int tid = threadIdx.x; asm volatile("" : "+v"(tid));
    const int lane = tid & 63, wave = tid >> 6;
    unsigned char* ws = a.ws;
    s5_tables(a, lds, (bid >> 3) & 31, bid & 7);
    const int bid2 = bid, G2 = G;
    const long gtid = (long)bid2 * NTHREADS + tid, gstr = (long)G2 * NTHREADS;
    {
        LAS float* scr = (LAS float*)(lds + wave * 8448);
        constexpr int I0 = 16 * (NE_IN / 32), I1 = 8 * 16, I2 = 16 * 32, I3 = 16 * (NO_PAD / 32), I4 = 16 * 32;
        for (int it = bid * 8 + wave; it < I0 + I1 + I2 + I3 + I4; it += G * 8) {
            int r = it;
            if (r < I0) { conv_w<1>(a.e_w_in, 1024, NE_IN, (h16*)(ws + WS_WE_IN), NE_IN, nullptr, scr, r, lane); continue; } r -= I0;
            if (r < I1) { conv_w<0>(a.e_w_glu, 512, 512, (h16*)(ws + WS_WGLU), 512, nullptr, scr, r, lane); continue; } r -= I1;
            if (r < I2) { conv_w<0>(a.e_w_out, 1024, 1024, (h16*)(ws + WS_WE_OUT), 1024, nullptr, scr, r, lane); continue; } r -= I2;
            if (r < I3) { conv_w<2>(a.o_w_in, 1024, NO_IN, (h16*)(ws + WS_WO_IN), NO_PAD, a.norm_g + 1024, scr, r, lane); continue; } r -= I3;
            conv_w<0>(a.o_w_out, 1024, 1024, (h16*)(ws + WS_WO_OUT), 1024, nullptr, scr, r, lane);
        }
    }
    for (long idx = gtid; idx < 4096 * 8; idx += gstr) {
        const int pos = (int)(idx >> 3), i = (int)(idx & 7);
        const float inv = i == 0 ? 0x1.0000000000000p+0f : i == 1 ? 0x1.8d275e0000000p-3f : i == 2 ? 0x1.3411900000000p-5f : i == 3 ? 0x1.ddee9c0000000p-8f
                        : i == 4 ? 0x1.72ba440000000p-10f : i == 5 ? 0x1.1f91f00000000p-12f : i == 6 ? 0x1.be218a0000000p-15f : 0x1.5a0f500000000p-17f;
        const float ang = (float)pos * inv; float s, c; sincosf(ang, &s, &c);
        float* r = (float*)(ws + WS_ROPE) + idx * 2; r[0] = c; r[1] = s;
    }
    h16* XN = (h16*)(ws + WS_XN);
    for (int row = bid2 * 8 + wave; row < MTOK; row += G2 * 8) {
        const f32x4* xr = (const f32x4*)(a.x + (size_t)row * 1024) + lane;
        f32x4 v[4]; float s = 0.f;
#pragma unroll
        for (int j = 0; j < 4; ++j) { v[j] = xr[64 * j]; s += (v[j][0] * v[j][0] + v[j][1] * v[j][1]) + (v[j][2] * v[j][2] + v[j][3] * v[j][3]); }
        const float rs = 1.0f / sqrtf(wave_sum(s) * (1.0f / 1024.0f) + NORM_EPS);
#pragma unroll
        for (int j = 0; j < 4; ++j) { const f32x4 gg = *((const f32x4*)a.norm_g + lane + 64 * j); f16x4 o;
            o[0] = (h16)(v[j][0] * rs * gg[0]); o[1] = (h16)(v[j][1] * rs * gg[1]); o[2] = (h16)(v[j][2] * rs * gg[2]); o[3] = (h16)(v[j][3] * rs * gg[3]);
            *((f16x4*)(XN + (size_t)row * 1024) + lane + 64 * j) = o; }
    }
}

__device__ __forceinline__ void conv_phase(const Args& a, LAS unsigned char* lds, int G, int bid) {
    LAS h16* Hs = (LAS h16*)lds;
    LAS float* Cs = (LAS float*)(lds + 65536);
    const h16* HB = (const h16*)(a.ws + WS_HB); const h16* ZB = (const h16*)(a.ws + WS_ZB); h16* YC = (h16*)(a.ws + WS_YCAT);
    int tid = threadIdx.x; asm volatile("" : "+v"(tid));
    const int lane = tid & 63, wave = tid >> 6;
    const int cp = tid & 255, th = tid >> 8;
    for (int unit = bid; unit < 1024; unit += G) {
        const int b = unit >> 7, t0 = (unit & 127) * 32;
        for (int e = tid; e < 62 * 64; e += NTHREADS) {
            const int r = e >> 6, ch = e & 63, tok = t0 - 30 + r; f16x8 v = (f16x8){0, 0, 0, 0, 0, 0, 0, 0};
            if (tok >= 0) v = *(const f16x8*)(HB + ((size_t)(b * SEQ + tok)) * 512 + ch * 8);
            *(LAS f16x8*)(Hs + r * 512 + ch * 8) = v;
        }
        __syncthreads();
        {
            float w0[31], w1[31];
#pragma unroll
            for (int j = 0; j < 31; ++j) { const f32x2 w = *(const f32x2*)(a.e_conv_w + j * 512 + 2 * cp); w0[j] = w[0]; w1[j] = w[1]; }
            const f32x2 bias = *(const f32x2*)(a.e_conv_b + 2 * cp);
            float a0[16], a1[16];
#pragma unroll
            for (int t = 0; t < 16; ++t) { a0[t] = bias[0]; a1[t] = bias[1]; }
#pragma unroll
            for (int r = 0; r < 46; ++r) {
                const f16x2 hv = *(const LAS f16x2*)(Hs + (16 * th + r) * 512 + 2 * cp);
                const float h0 = (float)hv[0], h1 = (float)hv[1];
#pragma unroll
                for (int t = 0; t < 16; ++t) { const int j = r - t; if (j >= 0 && j <= 30) { a0[t] += w0[j] * h0; a1[t] += w1[j] * h1; } }
            }
#pragma unroll
            for (int t = 0; t < 16; ++t) *(LAS f32x2*)(Cs + (16 * th + t) * 512 + 2 * cp) = (f32x2){a0[t], a1[t]};
        }
        __syncthreads();
#pragma unroll
        for (int tt = 0; tt < 4; ++tt) {
            const int t = wave * 4 + tt; const size_t tok = (size_t)b * SEQ + t0 + t;
            const f32x4 c0 = *(const LAS f32x4*)(Cs + t * 512 + lane * 8), c1 = *(const LAS f32x4*)(Cs + t * 512 + lane * 8 + 4);
            const float mean = wave_sum((c0[0] + c0[1]) + (c0[2] + c0[3]) + (c1[0] + c1[1]) + (c1[2] + c1[3])) * (1.0f / 512.0f);
            const f32x4 d0 = c0 - mean, d1 = c1 - mean;
            const float var = wave_sum((d0[0] * d0[0] + d0[1] * d0[1]) + (d0[2] * d0[2] + d0[3] * d0[3]) + (d1[0] * d1[0] + d1[1] * d1[1]) + (d1[2] * d1[2] + d1[3] * d1[3])) * (1.0f / 512.0f);
            const float rstd = 1.0f / sqrtf(var + NORM_EPS);
            const f32x4 g0 = *(const f32x4*)(a.e_ln_g + lane * 8), g1 = *(const f32x4*)(a.e_ln_g + lane * 8 + 4), b0 = *(const f32x4*)(a.e_ln_b + lane * 8), b1 = *(const f32x4*)(a.e_ln_b + lane * 8 + 4);
            const f16x8 zb = *(const f16x8*)(ZB + tok * 512 + lane * 8);
            f32x4 o0, o1;
#pragma unroll
            for (int j = 0; j < 4; ++j) { o0[j] = siluf_(d0[j] * rstd * g0[j] + b0[j]) * (float)zb[j]; o1[j] = siluf_(d1[j] * rstd * g1[j] + b1[j]) * (float)zb[4 + j]; }
            *(f16x8*)(YC + tok * 1024 + 512 + lane * 8) = cvt8(o0, o1);
        }
        __syncthreads();
    }
}

__device__ __forceinline__ void scan_phase(const Args& a, LAS unsigned char* lds, int G, int bid) {
    int tid = threadIdx.x; asm volatile("" : "+v"(tid));
    const int lane = tid & 63, wave = tid >> 6;
    LAS f32x2* E = (LAS f32x2*)lds;
    for (int task = bid; task < 256; task += G) {
        const int g = task >> 3, b = task & 7, n = lane;
        const f32x2 abt = *(const f32x2*)((const float*)(a.ws + WS_ABT) + (size_t)(g * 64 + n) * 2);
        const float* se = (const float*)(a.ws + WS_SEND) + ((size_t)g * 2048 + b * 256 + wave * 32) * 128 + 2 * n;
        h16* up = (h16*)(a.ws + WS_UA) + ((size_t)g * 2048 + b * 256 + wave * 32) * 384 + 256 + 2 * n;
        f32x2 e[32];
#pragma unroll
        for (int k = 0; k < 32; ++k) e[k] = *(const f32x2*)(se + (size_t)k * 128);
        float sr = 0.f, si = 0.f;
#pragma unroll
        for (int k = 0; k < 32; ++k) {
            const float er = e[k][0], ei = e[k][1];
            e[k][0] = sr; e[k][1] = si;
            const float nr = abt[0] * sr - abt[1] * si + er, ni = abt[0] * si + abt[1] * sr + ei;
            sr = nr; si = ni;
        }
        E[wave * 64 + n] = (f32x2){sr, si};
        float pr = abt[0], pi = abt[1];
#pragma unroll
        for (int q = 0; q < 5; ++q) { const float tr = pr * pr - pi * pi, ti = 2.f * pr * pi; pr = tr; pi = ti; }
        __syncthreads();
        float cr = 0.f, ci = 0.f;
        for (int w = 0; w < wave; ++w) { const f32x2 ew = E[w * 64 + n]; const float tr = pr * cr - pi * ci + ew[0], ti = pr * ci + pi * cr + ew[1]; cr = tr; ci = ti; }
        float qr_ = 1.f, qi_ = 0.f;
#pragma unroll
        for (int k = 0; k < 32; ++k) {
            const float orr = e[k][0] + (qr_ * cr - qi_ * ci), oi = e[k][1] + (qr_ * ci + qi_ * cr);
            f16x2 o; o[0] = (h16)orr; o[1] = (h16)oi; *(f16x2*)(up + (size_t)k * 384) = o;
            const float tr = qr_ * abt[0] - qi_ * abt[1], ti = qr_ * abt[1] + qi_ * abt[0]; qr_ = tr; qi_ = ti;
        }
        __syncthreads();
    }
}

constexpr int SEL_CAP = 128;
__device__ __forceinline__ float relu_(float x) { const int i = __float_as_int(x); return __int_as_float(i > 0 ? i : 0); }
__device__ __forceinline__ unsigned sortkey(float s) { const unsigned u = __float_as_uint(s); return (u & 0x80000000u) ? ~u : (u | 0x80000000u); }

__device__ __forceinline__ void lds_add_u32(LAS unsigned* p, unsigned v) { asm volatile("ds_add_u32 %0, %1" :: "v"((unsigned)(size_t)p), "v"(v) : "memory"); }
__device__ __forceinline__ void lds_store_u16(LAS unsigned short* p, unsigned v) { asm volatile("ds_write_b16 %0, %1" :: "v"((unsigned)(size_t)p), "v"(v) : "memory"); }
__device__ __forceinline__ void lds_store_u64(LAS unsigned long long* p, unsigned long long v) { asm volatile("ds_write_b64 %0, %1" :: "v"((unsigned)(size_t)p), "v"(v) : "memory"); }
__device__ __forceinline__ int lds_add_rtn(LAS int* p, int v) { int r; asm volatile("ds_add_rtn_u32 %0, %1, %2\n\ts_waitcnt lgkmcnt(0)" : "=v"(r) : "v"((unsigned)(size_t)p), "v"(v) : "memory"); return r; }
constexpr int IDX_NBIN = 896, IDX_HW = IDX_NBIN / 2, IDX_RING = 64 * IDX_HW * 4, IDX_SEL = IDX_RING + 5 * 8192;
template <int MODE> __device__ __forceinline__ void idx_pass(const Args& a, LAS unsigned char* lds, int b, int c, const f16x8 (&af)[4][2], const f32x4 (&wr_)[4], int wave, int lane) {
    const h16* KI = (const h16*)(a.ws + WS_KI) + (size_t)b * SEQ * 64;
    LAS unsigned* hist = (LAS unsigned*)lds;
    LAS unsigned short* mask16 = (LAS unsigned short*)lds;
    LAS unsigned long long* cand = (LAS unsigned long long*)(lds + 32768);
    LAS int* sel = (LAS int*)(lds + IDX_SEL);
    const int g4 = lane >> 4;
    const int qa = wave * 8 + (((g4 & 1) << 1) | (g4 >> 1)), qb = qa + 4;
    int bsa = 0, bsb = 0;
    if (MODE == 1) { bsa = sel[qa]; bsb = sel[qb]; }
    const h16* ksrc = KI + (size_t)lane * 64 + wave * 8;
    const unsigned dmaoff = (unsigned)wave * 1024u;
    const LAS unsigned char* fb = lds + IDX_RING + g4 * 1024 + (lane & 15) * 16;
#define IDX_DMA(J) __builtin_amdgcn_global_load_lds((const unsigned*)(ksrc + (size_t)(J) * 4096), (LAS unsigned*)(lds + IDX_RING + ((J) % 5) * 8192 + dmaoff), 16, 0, 0)
    IDX_DMA(0); IDX_DMA(1); IDX_DMA(2); IDX_DMA(3);
    asm volatile("s_waitcnt vmcnt(3) lgkmcnt(0)\n\ts_barrier" ::: "memory");
    for (int gi = 0; gi <= c; ++gi) {
        IDX_DMA(gi + 4);
        const LAS unsigned char* fs = fb + (gi % 5) * 8192;
#pragma unroll
        for (int tt = 0; tt < 4; ++tt) {
            const int tile = gi * 4 + tt;
            const f16x8 b0 = *(const LAS f16x8*)(fs + tt * 256), b1 = *(const LAS f16x8*)(fs + 4096 + tt * 256);
            float part[4];
#pragma unroll
            for (int i = 0; i < 4; ++i) {
                f32x4 d = (f32x4){0.f, 0.f, 0.f, 0.f};
                d = __builtin_amdgcn_mfma_f32_16x16x32_f16(af[i][0], b0, d, 0, 0, 0);
                d = __builtin_amdgcn_mfma_f32_16x16x32_f16(af[i][1], b1, d, 0, 0, 0);
                part[i] = wr_[i][0] * relu_(d[0]) + wr_[i][1] * relu_(d[1]) + wr_[i][2] * relu_(d[2]) + wr_[i][3] * relu_(d[3]);
            }
            const auto sa = __builtin_amdgcn_permlane16_swap(__float_as_uint(part[0]), __float_as_uint(part[1]), false, false);
            const auto sb = __builtin_amdgcn_permlane16_swap(__float_as_uint(part[2]), __float_as_uint(part[3]), false, false);
            const float sA = (__uint_as_float(sa[0]) + __uint_as_float(sa[1])) + 0.0f, sB = (__uint_as_float(sb[0]) + __uint_as_float(sb[1])) + 0.0f;
            const int key = tile * 16 + (lane & 15);
            const int binA = (int)fminf(fmaxf(fmaf(sA, 32.f, 448.f), 0.f), (float)(IDX_NBIN - 1)), binB = (int)fminf(fmaxf(fmaf(sB, 32.f, 448.f), 0.f), (float)(IDX_NBIN - 1));
            if (MODE == 0) {
                lds_add_u32(hist + qa * IDX_HW + (binA >> 1), (binA & 1) ? 65536u : 1u);
                lds_add_u32(hist + qb * IDX_HW + (binB >> 1), (binB & 1) ? 65536u : 1u);
            } else {
                const unsigned long long mA = __ballot(binA > bsa), mB = __ballot(binB > bsb);
                if (lane < 4) { const int q = wave * 8 + (((lane & 1) << 1) | (lane >> 1)); lds_store_u16(mask16 + q * 256 + tile, (unsigned)(mA >> (16 * lane)) & 0xffffu); }
                else if (lane < 8) { const int l = lane - 4; const int q = wave * 8 + 4 + (((l & 1) << 1) | (l >> 1)); lds_store_u16(mask16 + q * 256 + tile, (unsigned)(mB >> (16 * l)) & 0xffffu); }
                if (binA == bsa) { const int p = lds_add_rtn(sel + 128 + qa, 1); if (p < SEL_CAP) lds_store_u64(cand + qa * SEL_CAP + p, ((unsigned long long)sortkey(sA) << 32) | (unsigned)(4095 - key)); }
                if (binB == bsb) { const int p = lds_add_rtn(sel + 128 + qb, 1); if (p < SEL_CAP) lds_store_u64(cand + qb * SEL_CAP + p, ((unsigned long long)sortkey(sB) << 32) | (unsigned)(4095 - key)); }
            }
        }
        asm volatile("s_waitcnt vmcnt(3) lgkmcnt(0)\n\ts_barrier" ::: "memory");
    }
    asm volatile("s_waitcnt vmcnt(0)" ::: "memory");
#undef IDX_DMA
}

__device__ __forceinline__ void idx_phase(const Args& a, LAS unsigned char* lds, int G, int bid) {
    int tid = threadIdx.x; asm volatile("" : "+v"(tid));
    const int lane = tid & 63, wave = tid >> 6;
    unsigned long long* MASK = (unsigned long long*)(a.ws + WS_MASK);
    for (int e = bid * NTHREADS + tid; e < NB * 4 * 4 * 64; e += G * NTHREADS) {
        const int q = e & 63, t = (e >> 6) & 3, c = (e >> 8) & 3, b = e >> 10;
        unsigned long long allsel = ~0ull; asm volatile("" : "+v"(allsel));
        if (t <= c) MASK[((size_t)(b * 64 + c) * 64 + t) * 64 + q] = allsel;
    }
    if (bid >= 240) return;
    const int b = bid / 30, j = bid % 30;
    LAS unsigned* hist = (LAS unsigned*)lds;
    LAS int* sel = (LAS int*)(lds + IDX_SEL);
    LAS unsigned* mask32 = (LAS unsigned*)lds;
    LAS unsigned long long* cand = (LAS unsigned long long*)(lds + 32768);
    for (int uu = 0; uu < 2; ++uu) {
        const int c = uu == 0 ? 63 - j : 4 + j;
        const size_t tok0 = (size_t)b * SEQ + c * 64;
        f16x8 af[4][2]; f32x4 wr_[4];
        {
            const h16* QI = (const h16*)(a.ws + WS_QI); const float* WI = (const float*)(a.ws + WS_WI);
#pragma unroll
            for (int i = 0; i < 4; ++i) {
                const size_t tq = tok0 + wave * 8 + 2 * i + ((lane & 15) >> 3);
                const h16* p = QI + tq * 512 + (lane & 7) * 64 + 8 * (lane >> 4);
                af[i][0] = *(const f16x8*)p; af[i][1] = *(const f16x8*)(p + 32);
                wr_[i] = *(const f32x4*)(WI + (tok0 + wave * 8 + 2 * i + (lane >> 5)) * 8 + 4 * ((lane >> 4) & 1));
            }
        }
        for (int e = tid; e < 64 * IDX_HW; e += NTHREADS) hist[e] = 0u;
        __syncthreads();
        idx_pass<0>(a, lds, b, c, af, wr_, wave, lane);
        __syncthreads();
        for (int ql = 0; ql < 8; ++ql) {
            const int q = wave * 8 + ql;
            unsigned cnt[14]; unsigned s = 0;
#pragma unroll
            for (int k = 0; k < 7; ++k) { const unsigned w = hist[q * IDX_HW + lane * 7 + k]; cnt[2 * k] = w & 0xffffu; cnt[2 * k + 1] = w >> 16; s += cnt[2 * k] + cnt[2 * k + 1]; }
            unsigned suf = s;
#pragma unroll
            for (int o = 1; o < 64; o <<= 1) { const unsigned t = __shfl_down(suf, o); if (lane + o < 64) suf += t; }
            const unsigned above = suf - s;
            if (suf >= 256u && above < 256u) {
                unsigned run = above; int bs = lane * 14; int need = 1;
#pragma unroll
                for (int k = 13; k >= 0; --k) { if (run < 256u && run + cnt[k] >= 256u) { bs = lane * 14 + k; need = 256 - (int)run; } run += cnt[k]; }
                sel[q] = bs; sel[64 + q] = need;
            }
        }
        __syncthreads();
        for (int e = tid; e < 8192; e += NTHREADS) mask32[e] = 0u;
        if (tid < 64) sel[128 + tid] = 0;
        __syncthreads();
        idx_pass<1>(a, lds, b, c, af, wr_, wave, lane);
        __syncthreads();
        for (int ql = 0; ql < 8; ++ql) {
            const int q = wave * 8 + ql; int n = sel[128 + q]; if (n > SEL_CAP) n = SEL_CAP; const int need = sel[64 + q];
            const unsigned long long c0 = lane < n ? cand[q * SEL_CAP + lane] : 0ull, c1 = (lane + 64) < n ? cand[q * SEL_CAP + lane + 64] : 0ull;
            int r0 = 0, r1 = 0;
            for (int i = 0; i < n; ++i) { const unsigned long long ci = cand[q * SEL_CAP + i]; r0 += (ci > c0) ? 1 : 0; r1 += (ci > c1) ? 1 : 0; }
            if (lane < n && r0 < need) { const int key = 4095 - (int)(c0 & 0xfffu); atomicOr((unsigned*)(mask32 + q * 128 + (key >> 5)), 1u << (key & 31)); }
            if (lane + 64 < n && r1 < need) { const int key = 4095 - (int)(c1 & 0xfffu); atomicOr((unsigned*)(mask32 + q * 128 + (key >> 5)), 1u << (key & 31)); }
        }
        __syncthreads();
        for (int e = tid; e < 64 * (c + 1); e += NTHREADS) {
            const int q = e & 63, t = e >> 6;
            MASK[((size_t)(b * 64 + c) * 64 + t) * 64 + q] = (unsigned long long)mask32[q * 128 + 2 * t] | ((unsigned long long)mask32[q * 128 + 2 * t + 1] << 32);
        }
        __syncthreads();
    }
}

__device__ __forceinline__ int crow(int r, int hi) { return (r & 3) + 8 * (r >> 2) + 4 * hi; }
#define ATT_THR 8.0f
constexpr int ATT_K = 0, ATT_V = 24576, ATT_M = 65536, ATT_Q = 69632, ATT_W = 102400;
__device__ __forceinline__ float bitsel_(int m, float a, unsigned cbits) { return __uint_as_float((__float_as_uint(a) & (unsigned)m) | (cbits & ~(unsigned)m)); }
__device__ __forceinline__ void att_tile(f32x16& s0, f32x16& s1, f32x16& n0, f32x16& n1, f16x8 (&pk)[4], f32x16& o0, f32x16& o1, float& lrun, float& mrun,
                                         const LAS unsigned char* qp, const LAS unsigned char* kn, const LAS unsigned char* vt, const unsigned long long mw, LAS float* wsf, const int hi, const int r32) {
    typedef short s16x8 __attribute__((ext_vector_type(8))); typedef short s16x4 __attribute__((ext_vector_type(4)));
    f16x8 kf[8];
#pragma unroll
    for (int d0 = 0; d0 < 2; ++d0) { kf[2 * d0] = *(const LAS f16x8*)(kn + d0 * 2048); kf[2 * d0 + 1] = *(const LAS f16x8*)(kn + d0 * 2048 + 512); }
    n0 = (f32x16){}; n1 = (f32x16){};
    f16x8 qr[4];
#pragma unroll
    for (int d0 = 0; d0 < 4; ++d0) qr[d0] = *(const LAS f16x8*)(qp + d0 * 1024);
    const int mlo = (int)(unsigned)(mw >> (4 * hi)), mhi = (int)(unsigned)(mw >> (32 + 4 * hi));
#define ATT_MF(j) do { if ((j) & 1) { n1 = __builtin_amdgcn_mfma_f32_32x32x16_f16(kf[j], qr[(j) >> 1], n1, 0, 0, 0); } \
                       else { n0 = __builtin_amdgcn_mfma_f32_32x32x16_f16(kf[j], qr[(j) >> 1], n0, 0, 0, 0); } } while (0)
#define ATT_MSK0(r) s0[r] = bitsel_(__builtin_amdgcn_sbfe(mlo, ((r) & 3) + 8 * ((r) >> 2), 1), s0[r], 0xff800000u)
#define ATT_MSK1(r) s1[r] = bitsel_(__builtin_amdgcn_sbfe(mhi, ((r) & 3) + 8 * ((r) >> 2), 1), s1[r], 0xff800000u)
    float mx;
    asm volatile("" : "+v"(kf[0]));
    ATT_MF(0);
    ATT_MSK0(0); ATT_MSK0(1); ATT_MSK0(2); ATT_MSK0(3); ATT_MSK0(4); ATT_MSK0(5); ATT_MSK0(6); ATT_MSK0(7);
    mx = fmaxf(fmaxf(s0[0], s0[1]), s0[2]); mx = fmaxf(fmaxf(mx, s0[3]), s0[4]); mx = fmaxf(fmaxf(mx, s0[5]), s0[6]); mx = fmaxf(mx, s0[7]);
    asm volatile("" : "+v"(kf[1]), "+v"(mx));
    ATT_MF(1);
    ATT_MSK0(8); ATT_MSK0(9); ATT_MSK0(10); ATT_MSK0(11); ATT_MSK0(12); ATT_MSK0(13); ATT_MSK0(14); ATT_MSK0(15);
    mx = fmaxf(fmaxf(mx, s0[8]), s0[9]); mx = fmaxf(fmaxf(mx, s0[10]), s0[11]); mx = fmaxf(fmaxf(mx, s0[12]), s0[13]); mx = fmaxf(fmaxf(mx, s0[14]), s0[15]);
    asm volatile("" : "+v"(kf[2]), "+v"(mx));
    ATT_MF(2);
    ATT_MSK1(0); ATT_MSK1(1); ATT_MSK1(2); ATT_MSK1(3); ATT_MSK1(4); ATT_MSK1(5); ATT_MSK1(6); ATT_MSK1(7);
    mx = fmaxf(fmaxf(mx, s1[0]), s1[1]); mx = fmaxf(fmaxf(mx, s1[2]), s1[3]); mx = fmaxf(fmaxf(mx, s1[4]), s1[5]); mx = fmaxf(fmaxf(mx, s1[6]), s1[7]);
    asm volatile("" : "+v"(kf[3]), "+v"(mx));
    ATT_MF(3);
    { const LAS unsigned char* kn2 = kn + 4096; asm volatile("" : "+v"(kn2), "+v"(mx));
#pragma unroll
      for (int d0 = 0; d0 < 2; ++d0) { kf[4 + 2 * d0] = *(const LAS f16x8*)(kn2 + d0 * 2048); kf[4 + 2 * d0 + 1] = *(const LAS f16x8*)(kn2 + d0 * 2048 + 512); } }
    ATT_MSK1(8); ATT_MSK1(9); ATT_MSK1(10); ATT_MSK1(11); ATT_MSK1(12); ATT_MSK1(13); ATT_MSK1(14); ATT_MSK1(15);
    mx = fmaxf(fmaxf(mx, s1[8]), s1[9]); mx = fmaxf(fmaxf(mx, s1[10]), s1[11]); mx = fmaxf(fmaxf(mx, s1[12]), s1[13]); mx = fmaxf(fmaxf(mx, s1[14]), s1[15]);
    asm volatile("" : "+v"(kf[4]), "+v"(mx));
    ATT_MF(4);
    { const auto rr = __builtin_amdgcn_permlane32_swap(__float_as_uint(mx), __float_as_uint(mx), false, false); mx = fmaxf(__uint_as_float(rr[0]), __uint_as_float(rr[1])); }
    const bool up = mx > mrun + ATT_THR;
    float mnew = up ? mx : mrun;
    const float alpha = __builtin_amdgcn_exp2f(mrun - mnew);
    mrun = mnew;
    asm volatile("" : "+v"(kf[5]), "+v"(mnew));
    ATT_MF(5);
    asm volatile("" : "+v"(kf[6]));
    ATT_MF(6);
    asm volatile("" : "+v"(kf[7]));
    ATT_MF(7);
#undef ATT_MF
#undef ATT_MSK0
#undef ATT_MSK1
    float rs = 0.f;
#define ATT_EX(S, r) do { S[r] = __builtin_amdgcn_exp2f(S[r] - mnew); rs += S[r]; } while (0)
#pragma unroll
    for (int ks = 0; ks < 4; ++ks) {
        s16x4 l0, h0, l1, h1;
        {
            unsigned vaddr = (unsigned)(size_t)(vt + ks * 1024);
            asm volatile("" : "+v"(vaddr), "+v"(rs));
            asm volatile("ds_read_b64_tr_b16 %0, %1" : "=v"(l0) : "v"(vaddr) : "memory");
            asm volatile("ds_read_b64_tr_b16 %0, %1 offset:512" : "=v"(h0) : "v"(vaddr) : "memory");
            asm volatile("ds_read_b64_tr_b16 %0, %1 offset:4096" : "=v"(l1) : "v"(vaddr) : "memory");
            asm volatile("ds_read_b64_tr_b16 %0, %1 offset:4608" : "=v"(h1) : "v"(vaddr) : "memory");
        }
        if (ks == 0) { ATT_EX(s0, 0); ATT_EX(s0, 1); ATT_EX(s0, 2); ATT_EX(s0, 3); ATT_EX(s0, 4); ATT_EX(s0, 5); ATT_EX(s0, 6); ATT_EX(s0, 7); }
        if (ks == 1) { ATT_EX(s0, 8); ATT_EX(s0, 9); ATT_EX(s0, 10); ATT_EX(s0, 11); ATT_EX(s0, 12); ATT_EX(s0, 13); ATT_EX(s0, 14); ATT_EX(s0, 15); }
        if (ks == 2) { ATT_EX(s1, 0); ATT_EX(s1, 1); ATT_EX(s1, 2); ATT_EX(s1, 3); ATT_EX(s1, 4); ATT_EX(s1, 5); ATT_EX(s1, 6); ATT_EX(s1, 7); }
        if (ks == 3) { ATT_EX(s1, 8); ATT_EX(s1, 9); ATT_EX(s1, 10); ATT_EX(s1, 11); ATT_EX(s1, 12); ATT_EX(s1, 13); ATT_EX(s1, 14); ATT_EX(s1, 15); }
        asm volatile("s_waitcnt lgkmcnt(0)" : "+v"(rs) :: "memory"); __builtin_amdgcn_sched_barrier(0);
        {
            const f16x8 v0 = __builtin_bit_cast(f16x8, (s16x8){l0[0], l0[1], l0[2], l0[3], h0[0], h0[1], h0[2], h0[3]}), v1 = __builtin_bit_cast(f16x8, (s16x8){l1[0], l1[1], l1[2], l1[3], h1[0], h1[1], h1[2], h1[3]});
            o0 = __builtin_amdgcn_mfma_f32_32x32x16_f16(pk[ks], v0, o0, 0, 0, 0);
            o1 = __builtin_amdgcn_mfma_f32_32x32x16_f16(pk[ks], v1, o1, 0, 0, 0);
            asm volatile("" : "+v"(mnew));
        }
#pragma unroll
        for (int j = 0; j < 8; ++j) pk[ks][j] = (h16)((ks < 2) ? s0[8 * (ks & 1) + j] : s1[8 * (ks & 1) + j]);
    }
#undef ATT_EX
    if (__any(up)) {
        if (hi == 0) wsf[r32] = alpha;
#pragma unroll
        for (int k = 0; k < 4; ++k) { const f32x4 al = *(const LAS f32x4*)(wsf + 8 * k + 4 * hi);
#pragma unroll
            for (int j = 0; j < 4; ++j) { o0[4 * k + j] *= al[j]; o1[4 * k + j] *= al[j]; } }
    }
    lrun = lrun * alpha + rs;
}

__device__ __forceinline__ void attn_phase(const Args& a, LAS unsigned char* lds, int G, int bid) {
    int tid = threadIdx.x; asm volatile("" : "+v"(tid));
    const int lane = tid & 63, wid = __builtin_amdgcn_readfirstlane(tid >> 6), r32 = lane & 31, hi = lane >> 5;
    const h16* Q = (const h16*)(a.ws + WS_Q); const h16* KB = (const h16*)(a.ws + WS_KB); const h16* VB = (const h16*)(a.ws + WS_VB);
    const h16* ZS = (const h16*)(a.ws + WS_ZS); h16* AO = (h16*)(a.ws + WS_AO);
    const unsigned long long* MASK = (const unsigned long long*)(a.ws + WS_MASK);
    LAS float* wsf = (LAS float*)(lds + ATT_W) + wid * 64;
    if (bid >= 256) return;
    const int bg = bid >> 3, s = bid & 7, b = bg >> 2, g = bg & 3;
#define ATT_WAITBAR(NA, NB) do { if (wid < 2) asm volatile("s_waitcnt vmcnt(" #NA ") lgkmcnt(0)\n\ts_barrier" ::: "memory"); else asm volatile("s_waitcnt vmcnt(" #NB ") lgkmcnt(0)\n\ts_barrier" ::: "memory"); } while (0)
    for (int ui = 0; ui < 8; ++ui) {
        const int k2 = ui >> 1, base = 16 * k2;
        const int c = (ui & 1) ? base + 15 - s : base + s;
        const size_t tok0 = (size_t)b * SEQ + c * 64;
        const int hh = g * 4 + (wid >> 1), qbase = 32 * (wid & 1);
        const size_t tq = tok0 + qbase + r32;
        f32x16 o0 = {}, o1 = {};
        float mrun = -1e30f, lrun = 0.f;
        const h16* ksrc = KB + ((size_t)b * SEQ + lane) * 256 + g * 64 + wid * 8;
        const h16* vsrc = VB + ((size_t)b * SEQ + 16 * (wid & 3) + (lane >> 2)) * 256 + g * 64 + (wid >> 2) * 32 + (lane & 3) * 8;
        const unsigned* msrc = (const unsigned*)(MASK + ((size_t)(b * 64 + c) * 64) * 64) + wid * 64 + lane;
        const int nT = c + 1;
        const LAS unsigned char* kb = lds + ATT_K + hi * 1024 + r32 * 16;
        const LAS unsigned char* vp = lds + ATT_V + ((lane >> 4) & 1) * 32 + (lane & 3) * 8 + (4 * hi + ((lane & 15) >> 2)) * 64;
        const LAS unsigned char* mp = lds + ATT_M + (qbase + r32) * 8;
        LAS unsigned char* qs = lds + ATT_Q + wid * 4096;
        const LAS unsigned char* qp = qs + lane * 16;
        const unsigned dmaoff = (unsigned)wid * 1024u;
#define ATT_DMA(J) do { const int j_ = (J); \
            __builtin_amdgcn_global_load_lds((const unsigned*)(ksrc + (size_t)j_ * 64 * 256), (LAS unsigned*)(lds + ATT_K + (j_ % 3) * 8192 + dmaoff), 16, 0, 0); \
            __builtin_amdgcn_global_load_lds((const unsigned*)(vsrc + (size_t)j_ * 64 * 256), (LAS unsigned*)(lds + ATT_V + (j_ % 5) * 8192 + dmaoff), 16, 0, 0); \
            if (wid < 2) __builtin_amdgcn_global_load_lds(msrc + (size_t)j_ * 128, (LAS unsigned*)(lds + ATT_M + (j_ & 7) * 512 + wid * 256), 4, 0, 0); } while (0)
        {
            f16x8 qv[4];
#pragma unroll
            for (int d0 = 0; d0 < 4; ++d0) qv[d0] = *(const f16x8*)(Q + tq * 1024 + hh * 64 + d0 * 16 + hi * 8);
#pragma unroll
            for (int d0 = 0; d0 < 4; ++d0) *(LAS f16x8*)(qs + d0 * 1024 + lane * 16) = qv[d0];
        }
        *(LAS f16x8*)(lds + ATT_V + 4 * 8192 + wid * 1024 + lane * 16) = (f16x8){};
        ATT_DMA(0); ATT_DMA(1); ATT_DMA(2);
        ATT_WAITBAR(5, 3);
        f32x16 sa0 = {}, sa1 = {}, sb0 = {}, sb1 = {};
#pragma unroll
        for (int d0 = 0; d0 < 4; ++d0) {
            const f16x8 k0 = *(const LAS f16x8*)(kb + d0 * 2048), k1 = *(const LAS f16x8*)(kb + d0 * 2048 + 512), qf = *(const LAS f16x8*)(qp + d0 * 1024);
            sa0 = __builtin_amdgcn_mfma_f32_32x32x16_f16(k0, qf, sa0, 0, 0, 0);
            sa1 = __builtin_amdgcn_mfma_f32_32x32x16_f16(k1, qf, sa1, 0, 0, 0);
        }
        f16x8 pk[4];
#pragma unroll
        for (int k = 0; k < 4; ++k) pk[k] = (f16x8){};
        asm volatile("s_waitcnt lgkmcnt(0)\n\ts_barrier" ::: "memory");
#define ATT_STEP(SC0, SC1, SN0, SN1, T) do { const int t_ = (T); \
            ATT_DMA(t_ + 3); \
            const unsigned long long mw_ = *(const LAS unsigned long long*)(mp + (t_ & 7) * 512); \
            att_tile(SC0, SC1, SN0, SN1, pk, o0, o1, lrun, mrun, qp, kb + ((t_ + 1) % 3) * 8192, vp + ((t_ + 4) % 5) * 8192, mw_, wsf, hi, r32); \
            ATT_WAITBAR(5, 3); } while (0)
        int t = 0;
        for (; t + 1 < nT; t += 2) { ATT_STEP(sa0, sa1, sb0, sb1, t); ATT_STEP(sb0, sb1, sa0, sa1, t + 1); }
        if (t < nT) ATT_STEP(sa0, sa1, sb0, sb1, t);
#undef ATT_STEP
#undef ATT_DMA
        asm volatile("s_waitcnt vmcnt(0)" ::: "memory");
        {
            typedef short s16x8 __attribute__((ext_vector_type(8)));
            const LAS unsigned char* vt = vp + ((nT - 1) % 5) * 8192;
#pragma unroll
            for (int ks = 0; ks < 4; ++ks) {
                const v4i16_t l0 = __builtin_amdgcn_ds_read_tr16_b64_v4i16((LAS v4i16_t*)(vt + ks * 1024)), h0 = __builtin_amdgcn_ds_read_tr16_b64_v4i16((LAS v4i16_t*)(vt + ks * 1024 + 512));
                const v4i16_t l1 = __builtin_amdgcn_ds_read_tr16_b64_v4i16((LAS v4i16_t*)(vt + 4096 + ks * 1024)), h1 = __builtin_amdgcn_ds_read_tr16_b64_v4i16((LAS v4i16_t*)(vt + 4096 + ks * 1024 + 512));
                const f16x8 v0 = __builtin_bit_cast(f16x8, (s16x8){l0[0], l0[1], l0[2], l0[3], h0[0], h0[1], h0[2], h0[3]}), v1 = __builtin_bit_cast(f16x8, (s16x8){l1[0], l1[1], l1[2], l1[3], h1[0], h1[1], h1[2], h1[3]});
                o0 = __builtin_amdgcn_mfma_f32_32x32x16_f16(pk[ks], v0, o0, 0, 0, 0);
                o1 = __builtin_amdgcn_mfma_f32_32x32x16_f16(pk[ks], v1, o1, 0, 0, 0);
            }
        }
        lrun += __shfl_xor(lrun, 32);
        if (hi == 0) wsf[r32] = 1.0f / lrun;
        const size_t orow0 = tok0 + qbase;
#pragma unroll
        for (int r = 0; r < 16; ++r) {
            const int q = crow(r, hi); const float li = wsf[q];
            const size_t off = (orow0 + q) * 1024 + hh * 64 + r32;
            AO[off] = (h16)(o0[r] * li * (float)ZS[off]);
            AO[off + 32] = (h16)(o1[r] * li * (float)ZS[off + 32]);
        }
        __syncthreads();
    }
#undef ATT_WAITBAR
}

__device__ __forceinline__ void final_phase(const Args& a, int G, int bid) {
    int tid = threadIdx.x; asm volatile("" : "+v"(tid));
    const int lane = tid & 63, wave = tid >> 6;
    const float* rss = (const float*)(a.ws + WS_RSS2);
    for (int row = bid * 8 + wave; row < MTOK; row += G * 8) {
        const float rs = 1.0f / sqrtf(rss[row] * (1.0f / 1024.0f) + NORM_EPS);
        f32x4* p = (f32x4*)(a.out + (size_t)row * 1024) + lane;
#pragma unroll
        for (int j = 0; j < 4; ++j) { const f32x4 g = *((const f32x4*)a.final_g + lane + 64 * j); p[64 * j] = p[64 * j] * rs * g; }
    }
}

#define XB_TMO      128
#define XB_XCNT(j)  (256  + 64 * (j))
#define XB_XSUB(j)  (1280 + 64 * (j))
#define XB_XGEN(j)  (2304 + 64 * (j))
#define XB_TOP      3328
#define XB_TOPGEN   3392
#define XCD_BAR_WORDS 3456
#define XB_SPIN_CAP (1u << 18)
__device__ __forceinline__ unsigned xb_ld(unsigned* p)              { return __hip_atomic_load(p, __ATOMIC_RELAXED, __HIP_MEMORY_SCOPE_AGENT); }
__device__ __forceinline__ unsigned xb_add(unsigned* p, unsigned v) { return __hip_atomic_fetch_add(p, v, __ATOMIC_RELAXED, __HIP_MEMORY_SCOPE_AGENT); }
__device__ __forceinline__ unsigned xb_xcc_id() { return (unsigned)__builtin_amdgcn_s_getreg((3 << 11) | 20) & 0xFu; }
#define XB_SPIN(cond, bar) do { unsigned _sp = 0; while (cond) { __builtin_amdgcn_s_sleep(1); \
    if ((++_sp & 255u) == 0u) { if (xb_ld(&(bar)[XB_TMO])) break; if (_sp > XB_SPIN_CAP) { atomicAdd(&(bar)[XB_TMO], 1u); break; } } } } while (0)
struct XcdBarrier { unsigned* bar; unsigned x; volatile LAS unsigned* st; };
__device__ __forceinline__ XcdBarrier xcd_barrier_post(unsigned* bar, volatile LAS unsigned* st) {
    XcdBarrier b; b.bar = bar; b.x = xb_xcc_id(); b.st = st;
    if (threadIdx.x == 0) (void)xb_add(&bar[XB_XCNT(b.x)], 1u);
    return b;
}
__device__ __forceinline__ void xcd_barrier_complete(unsigned* bar, unsigned x, unsigned& nloc, unsigned& nx) {
    const unsigned G = gridDim.x * gridDim.y * gridDim.z;
    unsigned sum, cnt, mine, sp = 0u;
    for (;;) {
        sum = 0u; cnt = 0u; mine = 0u;
#pragma unroll
        for (unsigned j = 0; j < 16; ++j) { const unsigned c = xb_ld(&bar[XB_XCNT(j)]); sum += c; cnt += (c > 0u) ? 1u : 0u; mine = (j == x) ? c : mine; }
        if (sum == G) break;
        __builtin_amdgcn_s_sleep(1);
        if ((++sp & 255u) == 0u) { if (xb_ld(&bar[XB_TMO])) break; if (sp > XB_SPIN_CAP) { atomicAdd(&bar[XB_TMO], 1u); break; } }
    }
    nloc = mine > 0u ? mine : 1u; nx = cnt > 0u ? cnt : 1u;
}
__device__ __forceinline__ void xcd_barrier(const XcdBarrier& b) {
    asm volatile("s_waitcnt vmcnt(0)" ::: "memory");
    __syncthreads();
    if (threadIdx.x == 0) {
        unsigned* bar = b.bar;
        __builtin_amdgcn_s_waitcnt(0);
        unsigned nloc = b.st[0], nx = b.st[1];
        if (nloc == 0u) { xcd_barrier_complete(bar, b.x, nloc, nx); b.st[0] = nloc; b.st[1] = nx; }
        const unsigned old = xb_add(&bar[XB_XSUB(b.x)], 1u);
        const unsigned gen = old / nloc;
        if (old + 1u == (gen + 1u) * nloc) {
            __builtin_amdgcn_fence(__ATOMIC_RELEASE, "agent");
            asm volatile("s_waitcnt vmcnt(0)" ::: "memory");
            const unsigned og = xb_add(&bar[XB_TOP], 1u);
            const unsigned tg = og / nx;
            if (og + 1u == (tg + 1u) * nx) xb_add(&bar[XB_TOPGEN], 1u);
            else XB_SPIN(xb_ld(&bar[XB_TOPGEN]) == tg, bar);
            __builtin_amdgcn_fence(__ATOMIC_ACQUIRE, "agent");
            xb_add(&bar[XB_XGEN(b.x)], 1u);
            asm volatile("s_waitcnt vmcnt(0)" ::: "memory");
        } else {
            XB_SPIN(xb_ld(&bar[XB_XGEN(b.x)]) == gen, bar);
            __builtin_amdgcn_fence(__ATOMIC_ACQUIRE, "agent");
            asm volatile("s_waitcnt vmcnt(0)" ::: "memory");
        }
    }
    __syncthreads();
}

__global__ void __launch_bounds__(NTHREADS, 2) mega(Args a) {
    extern __shared__ __attribute__((aligned(16))) unsigned char lds_raw[];
    LAS unsigned char* lds = (LAS unsigned char*)lds_raw;
    const int G = gridDim.x, bid = blockIdx.x;
    unsigned char* ws = a.ws;
#if ONE_LAUNCH
    volatile LAS unsigned* bst = (volatile LAS unsigned*)(lds + LDS_BYTES - 64);
    if (threadIdx.x < 2) bst[threadIdx.x] = 0u;
    __syncthreads();
    const XcdBarrier xbar = xcd_barrier_post((unsigned*)(ws + WS_BAR), bst);
#define SEAM() xcd_barrier(xbar)
#else
#define SEAM() do {} while (0)
#endif
    for (int ph = a.ph_lo; ph < a.ph_hi; ++ph) {
      for (int rep = 0; rep < (((PH_REP >> ph) & 1) ? 2 : 1); ++rep) {
        if (rep) { SEAM(); }
        GemmP g{nullptr, nullptr, 1024, 1024, 1024, 0, 0, MTOK / 256, 4, 0}; int mode = -1;
        if (ph == 1) { g.A = (const char*)(ws + WS_XN); g.Bt = (const char*)(ws + WS_WE_IN); g.nN = NE_IN / 256; mode = E_EVEN_IN; }
        else if (ph == 2) { g = GemmP{(const char*)(ws + WS_UA), (const char*)(ws + WS_MS), 384, 256, 256, 2048L * 384 * 2, 256L * 256 * 2, 8, 1, 32}; mode = E_SEND; }
        else if (ph == 4) { g = GemmP{(const char*)(ws + WS_UA), (const char*)(ws + WS_MY), 384, 384, 384, 2048L * 384 * 2, 256L * 384 * 2, 8, 1, 32}; mode = E_Y; }
        else if (ph == 5) { g = GemmP{(const char*)(ws + WS_GG), (const char*)(ws + WS_WGLU), 512, 512, 512, 0, 0, MTOK / 256, 2, 0}; mode = E_GLU; }
        else if (ph == 6) { g.A = (const char*)(ws + WS_YCAT); g.Bt = (const char*)(ws + WS_WE_OUT); mode = E_OUT_EVEN; }
        else if (ph == 7) { g.A = (const char*)(ws + WS_XN); g.Bt = (const char*)(ws + WS_WO_IN); g.nN = NO_PAD / 256; mode = E_ODD_IN; }
        else if (ph == 10) { g.A = (const char*)(ws + WS_AO); g.Bt = (const char*)(ws + WS_WO_OUT); mode = E_OUT_ODD; }
#ifdef FIXED_MODE
        if (mode >= 0 && ((PH_EN >> ph) & 1)) gemm_phase(lds, g, FIXED_MODE, a, G, bid);
#else
        if (mode >= 0 && ((PH_EN >> ph) & 1)) gemm_phase(lds, g, mode, a, G, bid);
#endif
        if (ph == 0 && (PH_EN & 1)) p0_prologue(a, lds, G, bid);
        else if (ph == 1 && (PH_EN & 2)) s5_fill(a, G, bid);
        else if (ph == 2 && (PH_EN & 4)) { __syncthreads(); conv_phase(a, lds, G, bid); }
        else if (ph == 3 && (PH_EN & 8)) scan_phase(a, lds, G, bid);
        else if (ph == 8 && (PH_EN & 0x100)) idx_phase(a, lds, G, bid);
        else if (ph == 9 && (PH_EN & 0x200)) attn_phase(a, lds, G, bid);
        else if (ph == 11 && (PH_EN & 0x800)) final_phase(a, G, bid);
      }
        if (ph + 1 < a.ph_hi) { SEAM(); }
#ifdef XSYNC
        if (ph == 5) { for (int xs = 0; xs < XSYNC; ++xs) { SEAM(); } }
#endif
    }
}

extern "C" void kernel_launch(void* const* d_in, const int* in_sizes, int n_in, void* d_out, int out_size, void* d_ws, size_t ws_size, hipStream_t stream) {
    static int grid = 0;
    if (grid == 0) {
        if (n_in != 21 || out_size != MTOK * DM || ws_size < WS_END) { fprintf(stderr, "kernel_launch: unexpected problem (n_in %d, out %d, ws %zu)\n", n_in, out_size, ws_size); grid = -1; return; }
        if (hipFuncSetAttribute((const void*)mega, hipFuncAttributeMaxDynamicSharedMemorySize, LDS_BYTES) != hipSuccess) { fprintf(stderr, "kernel_launch: hipFuncSetAttribute failed\n"); grid = -1; return; }
        int dev = 0, cus = 0, per_cu = 0;
        (void)hipGetDevice(&dev); (void)hipDeviceGetAttribute(&cus, hipDeviceAttributeMultiprocessorCount, dev);
        (void)hipOccupancyMaxActiveBlocksPerMultiprocessor(&per_cu, (const void*)mega, NTHREADS, LDS_BYTES);
        if (per_cu < 1 || cus != 256) { fprintf(stderr, "kernel_launch: occupancy %d blocks/CU, %d CUs: this kernel needs 1 block on each of 256 CUs\n", per_cu, cus); grid = -1; return; }
        grid = 256;
    }
    if (grid < 0) return;
    (void)hipMemsetAsync((char*)d_ws, 0, CTL_ZERO_BYTES, stream);
    Args a{};
    const float** ap = (const float**)&a;
    for (int i = 0; i < 21; ++i) ap[i] = (const float*)d_in[i];
    a.out = (float*)d_out; a.ws = (unsigned char*)d_ws;
#if ONE_LAUNCH
    a.ph_lo = 0; a.ph_hi = NPHASE;
    void* args[] = {&a};
    hipError_t e = hipLaunchCooperativeKernel((const void*)mega, dim3(grid), dim3(NTHREADS), args, LDS_BYTES, stream);
    if (e != hipSuccess) fprintf(stderr, "cooperative launch failed: %s\n", hipGetErrorString(e));
#else
    for (int ph = 0; ph < NPHASE; ++ph) { a.ph_lo = ph; a.ph_hi = ph + 1; hipLaunchKernelGGL(mega, dim3(grid), dim3(NTHREADS), LDS_BYTES, stream, a); }
#endif
}
```

```cpp
#include <hip/hip_runtime.h>
#include <hip/hip_cooperative_groups.h>
#include <cstdio>
#include <cstdint>
namespace cg = cooperative_groups;

#define LAS __attribute__((address_space(3)))
typedef _Float16 h16;
typedef _Float16 f16x8 __attribute__((ext_vector_type(8)));
typedef _Float16 f16x4 __attribute__((ext_vector_type(4)));
typedef _Float16 f16x2 __attribute__((ext_vector_type(2)));
typedef float f32x2 __attribute__((ext_vector_type(2)));
typedef float f32x4 __attribute__((ext_vector_type(4)));
typedef float f32x16 __attribute__((ext_vector_type(16)));
typedef unsigned u32x4 __attribute__((ext_vector_type(4)));
typedef short v4i16_t __attribute__((ext_vector_type(4)));

#ifndef PH_EN
#define PH_EN 0xFFF
#endif
#ifndef PH_REP
#define PH_REP 0
#endif
#ifndef ONE_LAUNCH
#define ONE_LAUNCH 1
#endif

constexpr int NB = 8, SEQ = 4096, DM = 1024, MTOK = NB * SEQ;
constexpr int NE_IN = 2560, NO_IN = 3144, NO_PAD = 3328;
constexpr float NORM_EPS = 1e-6f;
constexpr int NTHREADS = 512;
constexpr int LDS_BYTES = 163840;
constexpr int NPHASE = 12;

constexpr size_t MiB = 1u << 20;
constexpr size_t WS_RSS1 = 0, WS_RSS2 = 128 * 1024, WS_BAR = 256 * 1024, WS_PCNT = 272 * 1024, CTL_ZERO_BYTES = 272 * 1024 + 32 * 1024;
constexpr size_t WS_ROPE = 1 * MiB;
constexpr size_t WS_ABT = 1 * MiB + 512 * 1024;
constexpr size_t WS_WE_IN = 2 * MiB;
constexpr size_t WS_WGLU = 7 * MiB;
constexpr size_t WS_WE_OUT = 8 * MiB;
constexpr size_t WS_WO_IN = 10 * MiB;
constexpr size_t WS_WO_OUT = 17 * MiB;
constexpr size_t WS_MY = 19 * MiB;
constexpr size_t WS_MS = 25 * MiB;
constexpr size_t WS_S5T = 29 * MiB;
constexpr size_t WS_XN = 32 * MiB;
constexpr size_t WS_UA = 96 * MiB;
constexpr size_t WS_SEND = 144 * MiB;
constexpr size_t WS_ZA = 176 * MiB;
constexpr size_t WS_HB = 208 * MiB;
constexpr size_t WS_ZB = 240 * MiB;
constexpr size_t WS_GG = 272 * MiB;
constexpr size_t WS_YCAT = 304 * MiB;
constexpr size_t WS_Q = 96 * MiB;
constexpr size_t WS_ZS = 160 * MiB;
constexpr size_t WS_KB = 224 * MiB;
constexpr size_t WS_VB = 240 * MiB;
constexpr size_t WS_QI = 256 * MiB;
constexpr size_t WS_KI = 288 * MiB;
constexpr size_t WS_WI = 292 * MiB;
constexpr size_t WS_MASK = 296 * MiB;
constexpr size_t WS_AO = 312 * MiB;
constexpr size_t WS_END = 376 * MiB;

struct Args {
    const float* x; const float* norm_g; const float* e_w_in; const float* e_lam_re; const float* e_lam_im; const float* e_log_step;
    const float* e_b_re; const float* e_b_im; const float* e_c_re; const float* e_c_im; const float* e_d_skip; const float* e_w_glu; const float* e_b_glu;
    const float* e_conv_w; const float* e_conv_b; const float* e_ln_g; const float* e_ln_b; const float* e_w_out; const float* o_w_in; const float* o_w_out; const float* final_g;
    float* out; unsigned char* ws; int ph_lo, ph_hi;
};

__device__ __forceinline__ float wave_sum(float v) {
#pragma unroll
    for (int o = 1; o < 64; o <<= 1) v += __shfl_xor(v, o);
    return v;
}
__device__ __forceinline__ float sigmoidf_(float x) { return __builtin_amdgcn_rcpf(1.0f + __builtin_amdgcn_exp2f(-1.4426950408889634f * x)); }
__device__ __forceinline__ float siluf_(float x) { return x * sigmoidf_(x); }
__device__ __forceinline__ float gelu_tanh(float x) {
    const float u2 = 1.5957691216057308f * (x + 0.044715f * x * x * x);
    return x * sigmoidf_(u2);
}
__device__ __forceinline__ f16x8 cvt8(const f32x4 a, const f32x4 b) {
    f16x8 o; o[0] = (h16)a[0]; o[1] = (h16)a[1]; o[2] = (h16)a[2]; o[3] = (h16)a[3]; o[4] = (h16)b[0]; o[5] = (h16)b[1]; o[6] = (h16)b[2]; o[7] = (h16)b[3]; return o;
}

constexpr int BM = 256, BK = 64, HALF = 128, HTB = HALF * BK * 2, STAGE_BYTES = 8 * HTB;
__device__ __forceinline__ int lds_byte(int r, int c) { const int st = (r >> 4) * 2 + (c >> 5), rr = r & 15, cc = c & 31, ob = rr * 64 + cc * 2; return st * 1024 + (ob ^ (((ob >> 9) & 1) << 5)); }
__device__ __forceinline__ void stage_rc(int b, int& R, int& C) { const int st = b / 1024, sb = b % 1024, swz = sb ^ (((sb >> 9) & 1) << 5); R = (st >> 1) * 16 + swz / 64; C = (st & 1) * 32 + (swz % 64) / 2; }
__device__ __forceinline__ int perm32(int rho) { const int n = rho >> 4, i = rho & 15; return 8 * (i >> 2) + 4 * n + (i & 3); }

struct Unit { int pm, pn, grp; };
struct GemmP { const char* A; const char* Bt; int lda, ldb, K; long gsA, gsB; int nM, nN, ngrp; };

__device__ __forceinline__ bool unit_next(const GemmP& g, int i, int G, int c, Unit& u) {
    const long Lx = (long)i * G + c;
    const bool grouped = g.ngrp > 0;
    const int nwg = grouped ? g.nM * g.ngrp : g.nM * g.nN;
    const bool ok = Lx < (long)nwg;
    const int L0 = ok ? (int)Lx : 0;
    const int gpm = L0 % g.nM, ggrp = L0 / g.nM;
    int wgid = L0; { const int q = nwg / 8, r = nwg % 8, xcd = wgid % 8, off = wgid / 8; wgid = (xcd < r ? xcd * (q + 1) : r * (q + 1) + (xcd - r) * q) + off; }
    const int nig = 8 * g.nN, gid = wgid / nig, fm = gid * 8, gsz = (g.nM - fm) < 8 ? (g.nM - fm) : 8;
    const int dpm = fm + ((wgid % nig) % gsz), dpn = (wgid % nig) / gsz;
    Unit r; r.pm = grouped ? gpm : dpm; r.pn = grouped ? 0 : dpn; r.grp = grouped ? ggrp : 0;
    u = r; return ok;
}

enum EpiMode { E_EVEN_IN = 0, E_SEND = 1, E_Y = 2, E_GLU = 3, E_OUT_EVEN = 4, E_ODD_IN = 5, E_OUT_ODD = 6 };

__device__ __forceinline__ void epilogue(const int mode, const Args& a, const f32x4 (&acc)[2][2][4][2], const Unit& u, int wr, int wc, int fr, int fq) {
    asm volatile("" : "+v"(fr), "+v"(fq));
    unsigned char* ws = a.ws;
    const int colw = 32 * wc + 8 * fq;
    if (mode == E_EVEN_IN) {
        const int pn = u.pn;
        if (pn >= 4 && pn < 8) {
            h16* HB = (h16*)(ws + WS_HB);
#pragma unroll
            for (int ai = 0; ai < 2; ++ai)
#pragma unroll
                for (int m = 0; m < 4; ++m) {
                    const int row = u.pm * BM + ai * HALF + wr * 64 + m * 16 + fr;
                    f32x4 o0, o1;
#pragma unroll
                    for (int j = 0; j < 4; ++j) { o0[j] = acc[ai][0][m][0][j] * sigmoidf_(acc[ai][1][m][0][j]); o1[j] = acc[ai][0][m][1][j] * sigmoidf_(acc[ai][1][m][1][j]); }
                    *(f16x8*)(HB + (size_t)row * 512 + (pn - 4) * 128 + colw) = cvt8(o0, o1);
                }
        } else {
#pragma unroll
            for (int ai = 0; ai < 2; ++ai)
#pragma unroll
                for (int m = 0; m < 4; ++m) {
                    const int row = u.pm * BM + ai * HALF + wr * 64 + m * 16 + fr;
#pragma unroll
                    for (int bj = 0; bj < 2; ++bj) {
                        const int col = pn * BM + bj * HALF + colw;
                        f32x4 v0 = acc[ai][bj][m][0], v1 = acc[ai][bj][m][1];
                        if (pn < 2) {
                            const int g = col >> 4;
                            h16* p = (h16*)(ws + WS_UA) + (size_t)g * (2048 * 384) + (size_t)(row >> 4) * 384 + (row & 15) * 16 + (col & 15);
                            *(f16x8*)p = cvt8(v0, v1);
                        } else {
#pragma unroll
                            for (int j = 0; j < 4; ++j) { v0[j] = siluf_(v0[j]); v1[j] = siluf_(v1[j]); }
                            if (pn < 4) *(f16x8*)((h16*)(ws + WS_ZA) + (size_t)row * 512 + (col - 512)) = cvt8(v0, v1);
                            else        *(f16x8*)((h16*)(ws + WS_ZB) + (size_t)row * 512 + (col - 2048)) = cvt8(v0, v1);
                        }
                    }
                }
        }
    } else if (mode == E_SEND) {
        float* SE = (float*)(ws + WS_SEND) + (size_t)u.grp * (2048 * 128);
#pragma unroll
        for (int ai = 0; ai < 2; ++ai)
#pragma unroll
            for (int m = 0; m < 4; ++m) {
                const int row = u.pm * BM + ai * HALF + wr * 64 + m * 16 + fr;
                float* p = SE + (size_t)row * 128 + colw;
                *(f32x4*)p = acc[ai][0][m][0]; *(f32x4*)(p + 4) = acc[ai][0][m][1];
            }
    } else if (mode == E_Y) {
        const h16* UA = (const h16*)(ws + WS_UA) + (size_t)u.grp * (2048 * 384);
        h16* GG = (h16*)(ws + WS_GG);
#pragma unroll
        for (int bj = 0; bj < 2; ++bj) {
            const int col = bj * HALF + colw, t = col >> 4, c0 = col & 15;
            const f32x4 d0 = *(const f32x4*)(a.e_d_skip + u.grp * 16 + c0), d1 = *(const f32x4*)(a.e_d_skip + u.grp * 16 + c0 + 4);
#pragma unroll
            for (int ai = 0; ai < 2; ++ai)
#pragma unroll
                for (int m = 0; m < 4; ++m) {
                    const int row = u.pm * BM + ai * HALF + wr * 64 + m * 16 + fr;
                    const f16x8 uu = *(const f16x8*)(UA + (size_t)row * 384 + col);
                    f32x4 o0, o1;
#pragma unroll
                    for (int j = 0; j < 4; ++j) { o0[j] = gelu_tanh(acc[ai][bj][m][0][j] + (float)uu[j] * d0[j]); o1[j] = gelu_tanh(acc[ai][bj][m][1][j] + (float)uu[4 + j] * d1[j]); }
                    *(f16x8*)(GG + ((size_t)row * 16 + t) * 512 + u.grp * 16 + c0) = cvt8(o0, o1);
                }
        }
    } else if (mode == E_GLU) {
        const h16* GG = (const h16*)(ws + WS_GG); const h16* ZA = (const h16*)(ws + WS_ZA); h16* YC = (h16*)(ws + WS_YCAT);
#pragma unroll
        for (int bj = 0; bj < 2; ++bj) {
            const int col = u.pn * BM + bj * HALF + colw;
            const f32x4 b0 = *(const f32x4*)(a.e_b_glu + col), b1 = *(const f32x4*)(a.e_b_glu + col + 4);
#pragma unroll
            for (int ai = 0; ai < 2; ++ai)
#pragma unroll
                for (int m = 0; m < 4; ++m) {
                    const int row = u.pm * BM + ai * HALF + wr * 64 + m * 16 + fr;
                    const f16x8 gg = *(const f16x8*)(GG + (size_t)row * 512 + col), za = *(const f16x8*)(ZA + (size_t)row * 512 + col);
                    f32x4 o0, o1;
#pragma unroll
                    for (int j = 0; j < 4; ++j) { o0[j] = (float)gg[j] * sigmoidf_(acc[ai][bj][m][0][j] + b0[j]) * (float)za[j]; o1[j] = (float)gg[4 + j] * sigmoidf_(acc[ai][bj][m][1][j] + b1[j]) * (float)za[4 + j]; }
                    *(f16x8*)(YC + (size_t)row * 1024 + col) = cvt8(o0, o1);
                }
        }
    } else if (mode == E_OUT_ODD) {
        float* rss = (float*)(ws + WS_RSS2);
        unsigned* pcnt = (unsigned*)(ws + WS_PCNT) + u.pm * 64;
#pragma unroll
        for (int ai = 0; ai < 2; ++ai)
#pragma unroll
            for (int m = 0; m < 4; ++m) {
                const int row = u.pm * BM + ai * HALF + wr * 64 + m * 16 + fr;
                float ss = 0.f;
#pragma unroll
                for (int bj = 0; bj < 2; ++bj) {
                    const size_t off = (size_t)row * 1024 + u.pn * BM + bj * HALF + colw;
                    const f32x4 h0 = acc[ai][bj][m][0] + *(const f32x4*)(a.out + off), h1 = acc[ai][bj][m][1] + *(const f32x4*)(a.out + off + 4);
#pragma unroll
                    for (int j = 0; j < 4; ++j) ss += h0[j] * h0[j] + h1[j] * h1[j];
                }
                ss += __shfl_xor(ss, 16); ss += __shfl_xor(ss, 32);
                if (fq == 0) atomicAdd(rss + row, ss);
                asm volatile("" ::: "memory");
            }
        asm volatile("s_waitcnt vmcnt(0)" ::: "memory");
        __syncthreads();
        if (threadIdx.x == 0) {
            __hip_atomic_fetch_add(pcnt, 1u, __ATOMIC_RELAXED, __HIP_MEMORY_SCOPE_AGENT);
            unsigned sp = 0;
            while (__hip_atomic_load(pcnt, __ATOMIC_RELAXED, __HIP_MEMORY_SCOPE_AGENT) < 4u && ++sp < (1u << 22)) __builtin_amdgcn_s_sleep(2);
        }
        __syncthreads();
#pragma unroll
        for (int ai = 0; ai < 2; ++ai)
#pragma unroll
            for (int m = 0; m < 4; ++m) {
                const int row = u.pm * BM + ai * HALF + wr * 64 + m * 16 + fr;
                const float rs = __builtin_amdgcn_rsqf(__hip_atomic_load(rss + row, __ATOMIC_RELAXED, __HIP_MEMORY_SCOPE_AGENT) * (1.0f / 1024.0f) + NORM_EPS);
#pragma unroll
                for (int bj = 0; bj < 2; ++bj) {
                    const int col = u.pn * BM + bj * HALF + colw; const size_t off = (size_t)row * 1024 + col;
                    const f32x4 g0 = *(const f32x4*)(a.final_g + col), g1 = *(const f32x4*)(a.final_g + col + 4);
                    const f32x4 h0 = acc[ai][bj][m][0] + *(const f32x4*)(a.out + off), h1 = acc[ai][bj][m][1] + *(const f32x4*)(a.out + off + 4);
                    *(f32x4*)(a.out + off) = h0 * rs * g0; *(f32x4*)(a.out + off + 4) = h1 * rs * g1;
                }
                asm volatile("" ::: "memory");
            }
    } else if (mode == E_OUT_EVEN) {
        const float* base = (mode == E_OUT_EVEN) ? a.x : a.out;
        float* rss = (float*)(ws + (mode == E_OUT_EVEN ? WS_RSS1 : WS_RSS2));
        h16* H1 = (h16*)(ws + WS_XN);
#pragma unroll
        for (int ai = 0; ai < 2; ++ai)
#pragma unroll
            for (int m = 0; m < 4; ++m) {
                const int row = u.pm * BM + ai * HALF + wr * 64 + m * 16 + fr;
                float ss = 0.f;
#pragma unroll
                for (int bj = 0; bj < 2; ++bj) {
                    const int col = u.pn * BM + bj * HALF + colw;
                    const size_t off = (size_t)row * 1024 + col;
                    const f32x4 x0 = *(const f32x4*)(base + off), x1 = *(const f32x4*)(base + off + 4);
                    const f32x4 h0 = x0 + acc[ai][bj][m][0], h1 = x1 + acc[ai][bj][m][1];
                    *(f32x4*)(a.out + off) = h0; *(f32x4*)(a.out + off + 4) = h1;
                    if (mode == E_OUT_EVEN) *(f16x8*)(H1 + off) = cvt8(h0, h1);
#pragma unroll
                    for (int j = 0; j < 4; ++j) ss += h0[j] * h0[j] + h1[j] * h1[j];
                }
                ss += __shfl_xor(ss, 16); ss += __shfl_xor(ss, 32);
                if (fq == 0) atomicAdd(rss + row, ss);
            }
    } else if (mode == E_ODD_IN) {
        const int pn = u.pn;
        const float* rss = (const float*)(ws + WS_RSS1);
        const float* ROPE = (const float*)(ws + WS_ROPE);
#pragma unroll
        for (int ai = 0; ai < 2; ++ai)
#pragma unroll
            for (int m = 0; m < 4; ++m) {
                const int row = u.pm * BM + ai * HALF + wr * 64 + m * 16 + fr;
                const float rs = __builtin_amdgcn_rsqf(rss[row] * (1.0f / 1024.0f) + NORM_EPS);
                const int pos = row & (SEQ - 1);
#pragma unroll
                for (int bj = 0; bj < 2; ++bj) {
                    const int col = pn * BM + bj * HALF + colw;
                    f32x4 v0 = acc[ai][bj][m][0] * rs, v1 = acc[ai][bj][m][1] * rs;
                    const bool ropeT = (pn < 4) || pn == 8 || pn == 10 || pn == 11 || (pn == 12 && col < 3072 + 64);
                    if (ropeT && (col & 63) < 16) {
                        const int i0 = (col & 63) >> 1;
                        const f32x4 cs0 = *(const f32x4*)(ROPE + pos * 16 + i0 * 2), cs1 = *(const f32x4*)(ROPE + pos * 16 + i0 * 2 + 4);
                        f32x4 r0, r1;
                        r0[0] = v0[0] * cs0[0] - v0[1] * cs0[1]; r0[1] = v0[0] * cs0[1] + v0[1] * cs0[0];
                        r0[2] = v0[2] * cs0[2] - v0[3] * cs0[3]; r0[3] = v0[2] * cs0[3] + v0[3] * cs0[2];
                        r1[0] = v1[0] * cs1[0] - v1[1] * cs1[1]; r1[1] = v1[0] * cs1[1] + v1[1] * cs1[0];
                        r1[2] = v1[2] * cs1[2] - v1[3] * cs1[3]; r1[3] = v1[2] * cs1[3] + v1[3] * cs1[2];
                        v0 = r0; v1 = r1;
                    }
                    if (pn < 4) *(f16x8*)((h16*)(ws + WS_Q) + (size_t)row * 1024 + col) = cvt8(v0 * 0.18033688011112042f, v1 * 0.18033688011112042f);
                    else if (pn < 8) {
#pragma unroll
                        for (int j = 0; j < 4; ++j) { v0[j] = siluf_(v0[j]); v1[j] = siluf_(v1[j]); }
                        *(f16x8*)((h16*)(ws + WS_ZS) + (size_t)row * 1024 + (col - 1024)) = cvt8(v0, v1);
                    } else if (pn == 8) *(f16x8*)((h16*)(ws + WS_KB) + (size_t)row * 256 + (col - 2048)) = cvt8(v0, v1);
                    else if (pn == 9) *(f16x8*)((h16*)(ws + WS_VB) + (size_t)row * 256 + (col - 2304)) = cvt8(v0, v1);
                    else if (pn < 12) *(f16x8*)((h16*)(ws + WS_QI) + (size_t)row * 512 + (col - 2560)) = cvt8(v0, v1);
                    else {
                        const int cl = col - 3072;
                        if (cl < 64) *(f16x8*)((h16*)(ws + WS_KI) + (size_t)row * 64 + cl) = cvt8(v0, v1);
                        else if (cl == 64) { float* w = (float*)(ws + WS_WI) + (size_t)row * 8; *(f32x4*)w = v0 * 0.04419417382415922f; *(f32x4*)(w + 4) = v1 * 0.04419417382415922f; }
                    }
                }
            }
    }
}

__device__ __forceinline__ void gemm_phase(LAS unsigned char* lds, const GemmP g, const int mode, const Args& a, const int G, const int c) {
    int tid = threadIdx.x; asm volatile("" : "+v"(tid));
    const int wid = __builtin_amdgcn_readfirstlane(tid >> 6), lane = tid & 63, wr = wid >> 2, wc = wid & 3, fr = lane & 15, fq = lane >> 4;
    const int nt = g.K / BK;
    unsigned voffA[2], voffB[2];
#pragma unroll
    for (int i = 0; i < 2; ++i) { int R, C; stage_rc(tid * 16 + i * 8192, R, C); const int Rb = (R & ~31) + perm32(R & 31);
        voffA[i] = (unsigned)(R * g.lda + C) * 2u; voffB[i] = (unsigned)(Rb * g.ldb + C) * 2u; }
    const size_t kstep = (size_t)(BK * 2);
    const size_t hstepA = (size_t)HALF * g.lda * 2, hstepB = (size_t)HALF * g.ldb * 2;
    const unsigned ldsw = (unsigned)wid * 1024u;
    const int aoff = lds_byte(wr * 64 + fr, fq * 8), boff = lds_byte(wc * 32 + fr, fq * 8);
#define PG8_SA(b, h) (((b) * 2 + (h)) * HTB)
#define PG8_SB(b, h) ((4 + (b) * 2 + (h)) * HTB)
#define PG8_STAGE(bufoff, gbase, voff) do { _Pragma("unroll") for (int _i = 0; _i < 2; ++_i) \
        __builtin_amdgcn_global_load_lds((const unsigned*)((const char*)(gbase) + (voff)[_i]), (LAS unsigned*)(lds + (bufoff) + ldsw + _i * 8192), 16, 0, 0); } while (0)
#define PG8_LDA(dst, b, h) do { _Pragma("unroll") for (int m = 0; m < 4; ++m) _Pragma("unroll") for (int k = 0; k < 2; ++k) dst[m][k] = *(const LAS f16x8*)(lds + PG8_SA(b, h) + aoff + m * 2048 + k * 1024); } while (0)
#define PG8_LDB(dst, b, h) do { _Pragma("unroll") for (int n = 0; n < 2; ++n) _Pragma("unroll") for (int k = 0; k < 2; ++k) dst[n][k] = *(const LAS f16x8*)(lds + PG8_SB(b, h) + boff + n * 2048 + k * 1024); } while (0)
#define PG8_MMA(ai, bj, At, Bt) do { __builtin_amdgcn_s_setprio(1); _Pragma("unroll") for (int m = 0; m < 4; ++m) _Pragma("unroll") for (int n = 0; n < 2; ++n) _Pragma("unroll") for (int k = 0; k < 2; ++k) \
        acc[ai][bj][m][n] = __builtin_amdgcn_mfma_f32_16x16x32_f16(Bt[n][k], At[m][k], acc[ai][bj][m][n], 0, 0, 0); __builtin_amdgcn_s_setprio(0); } while (0)
#define PG8_WAIT_V(n) asm volatile("s_waitcnt vmcnt(" #n ")" ::: "memory")
#define PG8_WAIT_L(n) asm volatile("s_waitcnt lgkmcnt(" #n ")" ::: "memory")
#define PG8_BAR __builtin_amdgcn_s_barrier()
#define PG8_SCHED __builtin_amdgcn_sched_barrier(0)
    Unit cur, nxt; int ui = 0;
    if (!unit_next(g, 0, G, c, cur)) return;
    f32x4 acc[2][2][4][2];
#pragma unroll
    for (int a_ = 0; a_ < 2; ++a_)
#pragma unroll
        for (int b = 0; b < 2; ++b)
#pragma unroll
            for (int m = 0; m < 4; ++m)
#pragma unroll
                for (int n = 0; n < 2; ++n) acc[a_][b][m][n] = (f32x4){0.f, 0.f, 0.f, 0.f};
    f16x8 At[4][2], B0[2][2], B1[2][2];
    const char* cA = g.A + (size_t)cur.grp * g.gsA + (size_t)cur.pm * 2 * hstepA; const char* cB = g.Bt + (size_t)cur.grp * g.gsB + (size_t)cur.pn * 2 * hstepB;
    PG8_STAGE(PG8_SB(0, 0), cB, voffB); PG8_STAGE(PG8_SB(0, 1), cB + hstepB, voffB); PG8_STAGE(PG8_SA(0, 0), cA, voffA); PG8_STAGE(PG8_SA(0, 1), cA + hstepA, voffA);
    if (wr == 1) PG8_BAR;
    PG8_WAIT_V(2); PG8_BAR;
    PG8_STAGE(PG8_SB(1, 0), cB + kstep, voffB); PG8_STAGE(PG8_SA(1, 0), cA + kstep, voffA); PG8_STAGE(PG8_SB(1, 1), cB + hstepB + kstep, voffB);
    PG8_WAIT_V(6); PG8_BAR;
    for (;;) {
        const bool has_next = unit_next(g, ui + 1, G, c, nxt);
        const char* nA = has_next ? g.A + (size_t)nxt.grp * g.gsA + (size_t)nxt.pm * 2 * hstepA : cA; const char* nB = has_next ? g.Bt + (size_t)nxt.grp * g.gsB + (size_t)nxt.pn * 2 * hstepB : cB;
        for (int t = 0; t < nt; t += 2) {
            const bool last = (t == nt - 2);
            const char* a1 = cA + (size_t)(t + 1) * kstep;
            const char* a2 = last ? nA : cA + (size_t)(t + 2) * kstep; const char* b2 = last ? nB : cB + (size_t)(t + 2) * kstep;
            const char* a3 = a2 + kstep; const char* b3 = b2 + kstep;
            PG8_LDB(B0, 0, 0); PG8_LDB(B1, 0, 1); PG8_SCHED; PG8_LDA(At, 0, 0); PG8_STAGE(PG8_SA(1, 1), a1 + hstepA, voffA);
            PG8_WAIT_V(8); PG8_WAIT_L(0); PG8_BAR; PG8_MMA(0, 0, At, B0); PG8_MMA(0, 1, At, B1); PG8_BAR; PG8_SCHED;
            PG8_LDA(At, 0, 1); PG8_STAGE(PG8_SB(0, 0), b2, voffB); PG8_STAGE(PG8_SB(0, 1), b2 + hstepB, voffB); PG8_STAGE(PG8_SA(0, 0), a2, voffA);
            PG8_WAIT_V(8); PG8_WAIT_L(0); PG8_BAR; PG8_MMA(1, 0, At, B0); PG8_MMA(1, 1, At, B1); PG8_BAR; PG8_SCHED;
            PG8_LDB(B0, 1, 0); PG8_LDB(B1, 1, 1); PG8_SCHED; PG8_LDA(At, 1, 0); PG8_STAGE(PG8_SA(0, 1), a2 + hstepA, voffA);
            PG8_WAIT_V(8); PG8_WAIT_L(0); PG8_BAR; PG8_MMA(0, 0, At, B0); PG8_MMA(0, 1, At, B1); PG8_BAR; PG8_SCHED;
            PG8_LDA(At, 1, 1); PG8_STAGE(PG8_SB(1, 0), b3, voffB); PG8_STAGE(PG8_SB(1, 1), b3 + hstepB, voffB); PG8_STAGE(PG8_SA(1, 0), a3, voffA);
            PG8_WAIT_V(8); PG8_WAIT_L(0); PG8_BAR; PG8_MMA(1, 0, At, B0); PG8_MMA(1, 1, At, B1); PG8_BAR; PG8_SCHED;
        }
        if (wr == 0) PG8_BAR;
        epilogue(mode, a, acc, cur, wr, wc, fr, fq);
        if (!has_next) break;
#pragma unroll
        for (int a_ = 0; a_ < 2; ++a_)
#pragma unroll
            for (int b = 0; b < 2; ++b)
#pragma unroll
                for (int m = 0; m < 4; ++m)
#pragma unroll
                    for (int n = 0; n < 2; ++n) acc[a_][b][m][n] = (f32x4){0.f, 0.f, 0.f, 0.f};
        cur = nxt; cA = nA; cB = nB; ++ui;
        if (wr == 1) PG8_BAR;
    }
    PG8_WAIT_V(0);
    PG8_BAR;
#undef PG8_SA
#undef PG8_SB
#undef PG8_STAGE
#undef PG8_LDA
#undef PG8_LDB
#undef PG8_MMA
#undef PG8_WAIT_V
#undef PG8_WAIT_L
#undef PG8_BAR
#undef PG8_SCHED
}

__device__ __forceinline__ int src_col_e_in(int n) { if (n < 1024 || n >= 2048) return n; const int j = (n - 1024) >> 8, w = (n - 1024) & 255; return w < 128 ? 1024 + 128 * j + w : 1536 + 128 * j + (w - 128); }
__device__ __forceinline__ int rot_dim(int p) { return p < 16 ? ((p & 1) ? 8 + (p >> 1) : (p >> 1)) : p; }
__device__ __forceinline__ int src_col_o_in(int n) {
    if (n < 1024) return (n & ~63) + rot_dim(n & 63);
    if (n < 2048) return n;
    if (n < 2304) return (n & ~63) + rot_dim(n & 63);
    if (n < 2560) return n;
    if (n < 3136) return (n & ~63) + rot_dim(n & 63);
    if (n < NO_IN) return n;
    return -1;
}
template <int MAP> __device__ __forceinline__ void conv_w(const float* src, int K, int Nsrc, h16* dst, int Nout, const float* kscale, LAS float* scr, int item, int lane) {
    const int nblk = Nout / 32, kb = item / nblk, nb = item % nblk, k0 = 64 * kb, n0 = 32 * nb;
    const int m0 = (MAP == 1) ? src_col_e_in(n0) : (MAP == 2) ? src_col_o_in(n0) : n0;
    const int sb = m0 & ~31, sc = sb + (lane & 31);
#pragma unroll 8
    for (int i = 0; i < 32; ++i) { const int kk = 2 * i + (lane >> 5); scr[kk * 33 + (lane & 31)] = (sc >= 0 && sc < Nsrc) ? src[(size_t)(k0 + kk) * Nsrc + sc] : 0.f; }
    asm volatile("s_waitcnt lgkmcnt(0)" ::: "memory");
    const int cch = lane & 7;
    f32x4 ks0 = (f32x4){1.f, 1.f, 1.f, 1.f}, ks1 = ks0;
    if (kscale) { ks0 = *(const f32x4*)(kscale + k0 + 8 * cch); ks1 = *(const f32x4*)(kscale + k0 + 8 * cch + 4); }
#pragma unroll
    for (int j = 0; j < 4; ++j) {
        const int n = n0 + (lane >> 3) + 8 * j;
        const int m = (MAP == 1) ? src_col_e_in(n) : (MAP == 2) ? src_col_o_in(n) : n;
        f16x8 o = (f16x8){};
        if (m >= 0) { const LAS float* p = scr + (8 * cch) * 33 + (m - sb);
            o[0] = (h16)(p[0] * ks0[0]); o[1] = (h16)(p[33] * ks0[1]); o[2] = (h16)(p[66] * ks0[2]); o[3] = (h16)(p[99] * ks0[3]);
            o[4] = (h16)(p[132] * ks1[0]); o[5] = (h16)(p[165] * ks1[1]); o[6] = (h16)(p[198] * ks1[2]); o[7] = (h16)(p[231] * ks1[3]); }
        *(f16x8*)(dst + (size_t)n * K + k0 + 8 * cch) = o;
    }
    asm volatile("s_waitcnt lgkmcnt(0)" ::: "memory");
}

constexpr int S5T_PWR = 0, S5T_PWI = 1088, S5T_BBR = 2176, S5T_BBI = 3200, S5T_CR = 4224, S5T_CI = 5248, S5T_KT = 6272, S5T_STRIDE = 10368;
__device__ __forceinline__ void s5_tables(const Args& a, LAS unsigned char* lds, int g, int part) {
    LAS float* F = (LAS float*)lds;
    LAS float* PWr = F, *PWi = F + 1088, *KKr = F + 2176, *KKi = F + 2240, *BBr = F + 2304, *BBi = F + 3328, *Cr = F + 4352, *Ci = F + 5376;
    float* T = (float*)(a.ws + WS_S5T) + (size_t)g * S5T_STRIDE;
    int tid = threadIdx.x; asm volatile("" : "+v"(tid));
    const float dt = expf(a.e_log_step[g]);
    for (int e = tid; e < 1088; e += NTHREADS) {
        const int n = e / 17, j = e % 17;
        const float lr = fminf(a.e_lam_re[g * 64 + n], -1e-4f), li = a.e_lam_im[g * 64 + n];
        const float mag = expf((float)j * (lr * dt)); float s, c; sincosf((float)j * (li * dt), &s, &c);
        PWr[e] = mag * c; PWi[e] = mag * s;
    }
    if (tid < 64) {
        const int n = tid;
        const float lr = fminf(a.e_lam_re[g * 64 + n], -1e-4f), li = a.e_lam_im[g * 64 + n];
        float s, c, sh, ch; sincosf(li * dt, &s, &c); sincosf(0.5f * li * dt, &sh, &ch);
        const float em1 = expm1f(lr * dt);
        const float nr = em1 * c - 2.0f * sh * sh, ni = (em1 + 1.0f) * s, den = lr * lr + li * li;
        KKr[n] = (nr * lr + ni * li) / den; KKi[n] = (ni * lr - nr * li) / den;
        if (part == 0) { const float m16 = expf(16.0f * (lr * dt)); float s16, c16; sincosf(16.0f * (li * dt), &s16, &c16);
            float* abt = (float*)(a.ws + WS_ABT) + (size_t)(g * 64 + n) * 2; abt[0] = m16 * c16; abt[1] = m16 * s16; }
    }
    __syncthreads();
    for (int e = tid; e < 1024; e += NTHREADS) {
        { const int n = e >> 4, cc = e & 15; const float br = a.e_b_re[(size_t)(g * 64 + n) * 16 + cc], bi = a.e_b_im[(size_t)(g * 64 + n) * 16 + cc];
          BBr[e] = KKr[n] * br - KKi[n] * bi; BBi[e] = KKr[n] * bi + KKi[n] * br; }
        { const int cc = e >> 6, n = e & 63; Cr[e] = a.e_c_re[(size_t)(g * 16 + cc) * 64 + n]; Ci[e] = a.e_c_im[(size_t)(g * 16 + cc) * 64 + n]; }
    }
    __syncthreads();
    {
        const int e = part * 512 + tid, tau = e >> 8, cc = (e >> 4) & 15, cp = e & 15; float s = 0.f;
        for (int n = 0; n < 64; ++n) {
            const float cr = Cr[cc * 64 + n], ci = Ci[cc * 64 + n], pr = PWr[n * 17 + tau], pi = PWi[n * 17 + tau];
            const float tr = cr * pr - ci * pi, ti = cr * pi + ci * pr;
            s += tr * BBr[n * 16 + cp] - ti * BBi[n * 16 + cp];
        }
        T[S5T_KT + e] = s;
    }
    if (part == 0) { for (int e = tid; e < 6272; e += NTHREADS) T[e] = (e < 2176) ? F[e] : F[e + 128]; }
    __syncthreads();
}
__device__ __forceinline__ void s5_fill(const Args& a, int G, int bid) {
    int tid = threadIdx.x; asm volatile("" : "+v"(tid));
    const float* TB = (const float*)(a.ws + WS_S5T);
    for (int e = bid * NTHREADS + tid; e < 32 * 256 * 48; e += G * NTHREADS) {
        const int g = e / (256 * 48), r = e % (256 * 48), row = r / 48, cg = r % 48, t = row >> 4, cc = row & 15; const float* T = TB + (size_t)g * S5T_STRIDE; f16x8 o;
#pragma unroll
        for (int j = 0; j < 8; ++j) {
            const int col = cg * 8 + j; float v;
            if (col < 256) { const int tp = col >> 4, cp = col & 15; v = (t >= tp) ? T[S5T_KT + (t - tp) * 256 + cc * 16 + cp] : 0.f; }
            else { const int q = col - 256, n = q >> 1, ri = q & 1; const float cr = T[S5T_CR + cc * 64 + n], ci = T[S5T_CI + cc * 64 + n], pr = T[S5T_PWR + n * 17 + t + 1], pi = T[S5T_PWI + n * 17 + t + 1];
                   v = ri == 0 ? (cr * pr - ci * pi) : -(cr * pi + ci * pr); }
            o[j] = (h16)v;
        }
        *(f16x8*)((h16*)(a.ws + WS_MY) + (size_t)g * (256 * 384) + (size_t)row * 384 + cg * 8) = o;
    }
    for (int e = bid * NTHREADS + tid; e < 32 * 256 * 32; e += G * NTHREADS) {
        const int g = e >> 13, r = e & 8191, row = r >> 5, cg = r & 31; const float* T = TB + (size_t)g * S5T_STRIDE; f16x8 o;
#pragma unroll
        for (int j = 0; j < 8; ++j) {
            float v = 0.f;
            if (row < 128) { const int n = row >> 1, ri = row & 1, col = cg * 8 + j, tp = col >> 4, cp = col & 15;
                const float pr = T[S5T_PWR + n * 17 + 15 - tp], pi = T[S5T_PWI + n * 17 + 15 - tp], br = T[S5T_BBR + n * 16 + cp], bi = T[S5T_BBI + n * 16 + cp];
                v = ri == 0 ? (pr * br - pi * bi) : (pr * bi + pi * br); }
            o[j] = (h16)v;
        }
        *(f16x8*)((h16*)(a.ws + WS_MS) + (size_t)g * (256 * 256) + (size_t)row * 256 + cg * 8) = o;
    }
}

__device__ __forceinline__ void p0_prologue(const Args& a, LAS unsigned char* lds, int G, int bid) {
    int tid = threadIdx.x; asm volatile("" : "+v"(tid));
    const int lane = tid & 63, wave = tid >> 6;
    unsigned char* ws = a.ws;
    s5_tables(a, lds, (bid >> 3) & 31, bid & 7);
    const int bid2 = bid, G2 = G;
    const long gtid = (long)bid2 * NTHREADS + tid, gstr = (long)G2 * NTHREADS;
    {
        LAS float* scr = (LAS float*)(lds + wave * 8448);
        constexpr int I0 = 16 * (NE_IN / 32), I1 = 8 * 16, I2 = 16 * 32, I3 = 16 * (NO_PAD / 32), I4 = 16 * 32;
        for (int it = bid * 8 + wave; it < I0 + I1 + I2 + I3 + I4; it += G * 8) {
            int r = it;
            if (r < I0) { conv_w<1>(a.e_w_in, 1024, NE_IN, (h16*)(ws + WS_WE_IN), NE_IN, nullptr, scr, r, lane); continue; } r -= I0;
            if (r < I1) { conv_w<0>(a.e_w_glu, 512, 512, (h16*)(ws + WS_WGLU), 512, nullptr, scr, r, lane); continue; } r -= I1;
            if (r < I2) { conv_w<0>(a.e_w_out, 1024, 1024, (h16*)(ws + WS_WE_OUT), 1024, nullptr, scr, r, lane); continue; } r -= I2;
            if (r < I3) { conv_w<2>(a.o_w_in, 1024, NO_IN, (h16*)(ws + WS_WO_IN), NO_PAD, a.norm_g + 1024, scr, r, lane); continue; } r -= I3;
            conv_w<0>(a.o_w_out, 1024, 1024, (h16*)(ws + WS_WO_OUT), 1024, nullptr, scr, r, lane);
        }
    }
    for (long idx = gtid; idx < 4096 * 8; idx += gstr) {
        const int pos = (int)(idx >> 3), i = (int)(idx & 7);
        const float inv = i == 0 ? 0x1.0000000000000p+0f : i == 1 ? 0x1.8d275e0000000p-3f : i == 2 ? 0x1.3411900000000p-5f : i == 3 ? 0x1.ddee9c0000000p-8f
                        : i == 4 ? 0x1.72ba440000000p-10f : i == 5 ? 0x1.1f91f00000000p-12f : i == 6 ? 0x1.be218a0000000p-15f : 0x1.5a0f500000000p-17f;
        const float ang = (float)pos * inv; float s, c; sincosf(ang, &s, &c);
        float* r = (float*)(ws + WS_ROPE) + idx * 2; r[0] = c; r[1] = s;
    }
    h16* XN = (h16*)(ws + WS_XN);
    for (int row = bid2 * 8 + wave; row < MTOK; row += G2 * 8) {
        const f32x4* xr = (const f32x4*)(a.x + (size_t)row * 1024) + lane;
        f32x4 v[4]; float s = 0.f;
#pragma unroll
        for (int j = 0; j < 4; ++j) { v[j] = xr[64 * j]; s += (v[j][0] * v[j][0] + v[j][1] * v[j][1]) + (v[j][2] * v[j][2] + v[j][3] * v[j][3]); }
        const float rs = __builtin_amdgcn_rsqf(wave_sum(s) * (1.0f / 1024.0f) + NORM_EPS);
#pragma unroll
        for (int j = 0; j < 4; ++j) { const f32x4 gg = *((const f32x4*)a.norm_g + lane + 64 * j); f16x4 o;
            o[0] = (h16)(v[j][0] * rs * gg[0]); o[1] = (h16)(v[j][1] * rs * gg[1]); o[2] = (h16)(v[j][2] * rs * gg[2]); o[3] = (h16)(v[j][3] * rs * gg[3]);
            *((f16x4*)(XN + (size_t)row * 1024) + lane + 64 * j) = o; }
    }
}

__device__ __forceinline__ void conv_phase(const Args& a, LAS unsigned char* lds, int G, int bid) {
    LAS h16* Hs = (LAS h16*)lds;
    LAS float* Cs = (LAS float*)(lds + 65536);
    const h16* HB = (const h16*)(a.ws + WS_HB); const h16* ZB = (const h16*)(a.ws + WS_ZB); h16* YC = (h16*)(a.ws + WS_YCAT);
    int tid = threadIdx.x; asm volatile("" : "+v"(tid));
    const int lane = tid & 63, wave = tid >> 6;
    const int cp = tid & 255, th = tid >> 8;
    for (int unit = bid; unit < 1024; unit += G) {
        const int b = unit >> 7, t0 = (unit & 127) * 32;
        for (int e = tid; e < 62 * 64; e += NTHREADS) {
            const int r = e >> 6, ch = e & 63, tok = t0 - 30 + r; f16x8 v = (f16x8){0, 0, 0, 0, 0, 0, 0, 0};
            if (tok >= 0) v = *(const f16x8*)(HB + ((size_t)(b * SEQ + tok)) * 512 + ch * 8);
            *(LAS f16x8*)(Hs + r * 512 + ch * 8) = v;
        }
        __syncthreads();
        {
            float w0[31], w1[31];
#pragma unroll
            for (int j = 0; j < 31; ++j) { const f32x2 w = *(const f32x2*)(a.e_conv_w + j * 512 + 2 * cp); w0[j] = w[0]; w1[j] = w[1]; }
            const f32x2 bias = *(const f32x2*)(a.e_conv_b + 2 * cp);
            float a0[16], a1[16];
#pragma unroll
            for (int t = 0; t < 16; ++t) { a0[t] = bias[0]; a1[t] = bias[1]; }
#pragma unroll
            for (int r = 0; r < 46; ++r) {
                const f16x2 hv = *(const LAS f16x2*)(Hs + (16 * th + r) * 512 + 2 * cp);
                const float h0 = (float)hv[0], h1 = (float)hv[1];
#pragma unroll
                for (int t = 0; t < 16; ++t) { const int j = r - t; if (j >= 0 && j <= 30) { a0[t] += w0[j] * h0; a1[t] += w1[j] * h1; } }
            }
#pragma unroll
            for (int t = 0; t < 16; ++t) *(LAS f32x2*)(Cs + (16 * th + t) * 512 + 2 * cp) = (f32x2){a0[t], a1[t]};
        }
        __syncthreads();
#pragma unroll
        for (int tt = 0; tt < 4; ++tt) {
            const int t = wave * 4 + tt; const size_t tok = (size_t)b * SEQ + t0 + t;
            const f32x4 c0 = *(const LAS f32x4*)(Cs + t * 512 + lane * 8), c1 = *(const LAS f32x4*)(Cs + t * 512 + lane * 8 + 4);
            const float mean = wave_sum((c0[0] + c0[1]) + (c0[2] + c0[3]) + (c1[0] + c1[1]) + (c1[2] + c1[3])) * (1.0f / 512.0f);
            const f32x4 d0 = c0 - mean, d1 = c1 - mean;
            const float var = wave_sum((d0[0] * d0[0] + d0[1] * d0[1]) + (d0[2] * d0[2] + d0[3] * d0[3]) + (d1[0] * d1[0] + d1[1] * d1[1]) + (d1[2] * d1[2] + d1[3] * d1[3])) * (1.0f / 512.0f);
            const float rstd = __builtin_amdgcn_rsqf(var + NORM_EPS);
            const f32x4 g0 = *(const f32x4*)(a.e_ln_g + lane * 8), g1 = *(const f32x4*)(a.e_ln_g + lane * 8 + 4), b0 = *(const f32x4*)(a.e_ln_b + lane * 8), b1 = *(const f32x4*)(a.e_ln_b + lane * 8 + 4);
            const f16x8 zb = *(const f16x8*)(ZB + tok * 512 + lane * 8);
            f32x4 o0, o1;
#pragma unroll
            for (int j = 0; j < 4; ++j) { o0[j] = siluf_(d0[j] * rstd * g0[j] + b0[j]) * (float)zb[j]; o1[j] = siluf_(d1[j] * rstd * g1[j] + b1[j]) * (float)zb[4 + j]; }
            *(f16x8*)(YC + tok * 1024 + 512 + lane * 8) = cvt8(o0, o1);
        }
        __syncthreads();
    }
}

__device__ __forceinline__ void scan_phase(const Args& a, LAS unsigned char* lds, int G, int bid) {
    int tid = threadIdx.x; asm volatile("" : "+v"(tid));
    const int lane = tid & 63, wave = tid >> 6;
    LAS f32x2* E = (LAS f32x2*)lds;
    for (int task = bid; task < 256; task += G) {
        const int g = task >> 3, b = task & 7, n = lane;
        const f32x2 abt = *(const f32x2*)((const float*)(a.ws + WS_ABT) + (size_t)(g * 64 + n) * 2);
        const float* se = (const float*)(a.ws + WS_SEND) + ((size_t)g * 2048 + b * 256 + wave * 32) * 128 + 2 * n;
        h16* up = (h16*)(a.ws + WS_UA) + ((size_t)g * 2048 + b * 256 + wave * 32) * 384 + 256 + 2 * n;
        f32x2 e[32];
#pragma unroll
        for (int k = 0; k < 32; ++k) e[k] = *(const f32x2*)(se + (size_t)k * 128);
        float sr = 0.f, si = 0.f;
#pragma unroll
        for (int k = 0; k < 32; ++k) {
            const float er = e[k][0], ei = e[k][1];
            e[k][0] = sr; e[k][1] = si;
            const float nr = abt[0] * sr - abt[1] * si + er, ni = abt[0] * si + abt[1] * sr + ei;
            sr = nr; si = ni;
        }
        E[wave * 64 + n] = (f32x2){sr, si};
        float pr = abt[0], pi = abt[1];
#pragma unroll
        for (int q = 0; q < 5; ++q) { const float tr = pr * pr - pi * pi, ti = 2.f * pr * pi; pr = tr; pi = ti; }
        __syncthreads();
        float cr = 0.f, ci = 0.f;
        for (int w = 0; w < wave; ++w) { const f32x2 ew = E[w * 64 + n]; const float tr = pr * cr - pi * ci + ew[0], ti = pr * ci + pi * cr + ew[1]; cr = tr; ci = ti; }
        float qr_ = 1.f, qi_ = 0.f;
#pragma unroll
        for (int k = 0; k < 32; ++k) {
            const float orr = e[k][0] + (qr_ * cr - qi_ * ci), oi = e[k][1] + (qr_ * ci + qi_ * cr);
            f16x2 o; o[0] = (h16)orr; o[1] = (h16)oi; *(f16x2*)(up + (size_t)k * 384) = o;
            const float tr = qr_ * abt[0] - qi_ * abt[1], ti = qr_ * abt[1] + qi_ * abt[0]; qr_ = tr; qi_ = ti;
        }
        __syncthreads();
    }
}

constexpr int SEL_CAP = 128;
__device__ __forceinline__ float relu_(float x) { const int i = __float_as_int(x); return __int_as_float(i > 0 ? i : 0); }
__device__ __forceinline__ unsigned sortkey(float s) { const unsigned u = __float_as_uint(s); return (u & 0x80000000u) ? ~u : (u | 0x80000000u); }

__device__ __forceinline__ void lds_add_u32(LAS unsigned* p, unsigned v) { asm volatile("ds_add_u32 %0, %1" :: "v"((unsigned)(size_t)p), "v"(v) : "memory"); }
__device__ __forceinline__ void lds_store_u16(LAS unsigned short* p, unsigned v) { asm volatile("ds_write_b16 %0, %1" :: "v"((unsigned)(size_t)p), "v"(v) : "memory"); }
__device__ __forceinline__ void lds_store_u64(LAS unsigned long long* p, unsigned long long v) { asm volatile("ds_write_b64 %0, %1" :: "v"((unsigned)(size_t)p), "v"(v) : "memory"); }
__device__ __forceinline__ int lds_add_rtn(LAS int* p, int v) { int r; asm volatile("ds_add_rtn_u32 %0, %1, %2\n\ts_waitcnt lgkmcnt(0)" : "=v"(r) : "v"((unsigned)(size_t)p), "v"(v) : "memory"); return r; }
constexpr int IDX_NBIN = 896, IDX_HW = IDX_NBIN / 2, IDX_RING = 64 * IDX_HW * 4, IDX_SEL = IDX_RING + 5 * 8192;
template <int MODE> __device__ __forceinline__ void idx_pass(const Args& a, LAS unsigned char* lds, int b, int c, const f16x8 (&af)[4][2], const f32x4 (&wr_)[4], int wave, int lane) {
    const h16* KI = (const h16*)(a.ws + WS_KI) + (size_t)b * SEQ * 64;
    LAS unsigned* hist = (LAS unsigned*)lds;
    LAS unsigned short* mask16 = (LAS unsigned short*)lds;
    LAS unsigned long long* cand = (LAS unsigned long long*)(lds + 32768);
    LAS int* sel = (LAS int*)(lds + IDX_SEL);
    const int g4 = lane >> 4;
    const int qa = wave * 8 + (((g4 & 1) << 1) | (g4 >> 1)), qb = qa + 4;
    int bsa = 0, bsb = 0;
    if (MODE == 1) { bsa = sel[qa]; bsb = sel[qb]; }
    const h16* ksrc = KI + (size_t)lane * 64 + wave * 8;
    const unsigned dmaoff = (unsigned)wave * 1024u;
    const LAS unsigned char* fb = lds + IDX_RING + g4 * 1024 + (lane & 15) * 16;
#define IDX_DMA(J) __builtin_amdgcn_global_load_lds((const unsigned*)(ksrc + (size_t)(J) * 4096), (LAS unsigned*)(lds + IDX_RING + ((J) % 5) * 8192 + dmaoff), 16, 0, 0)
    IDX_DMA(0); IDX_DMA(1); IDX_DMA(2); IDX_DMA(3);
    asm volatile("s_waitcnt vmcnt(3) lgkmcnt(0)\n\ts_barrier" ::: "memory");
    for (int gi = 0; gi <= c; ++gi) {
        IDX_DMA(gi + 4);
        const LAS unsigned char* fs = fb + (gi % 5) * 8192;
#pragma unroll
        for (int hh = 0; hh < 2; ++hh) {
            f32x4 d[2][4];
#pragma unroll
            for (int t2 = 0; t2 < 2; ++t2) {
                const int tt = hh * 2 + t2;
                const f16x8 b0 = *(const LAS f16x8*)(fs + tt * 256), b1 = *(const LAS f16x8*)(fs + 4096 + tt * 256);
#pragma unroll
                for (int i = 0; i < 4; ++i) {
                    d[t2][i] = __builtin_amdgcn_mfma_f32_16x16x32_f16(af[i][0], b0, (f32x4){0.f, 0.f, 0.f, 0.f}, 0, 0, 0);
                    d[t2][i] = __builtin_amdgcn_mfma_f32_16x16x32_f16(af[i][1], b1, d[t2][i], 0, 0, 0);
                }
            }
#pragma unroll
            for (int t2 = 0; t2 < 2; ++t2) {
            const int tt = hh * 2 + t2;
            const int tile = gi * 4 + tt;
            float part[4];
#pragma unroll
            for (int i = 0; i < 4; ++i)
                part[i] = (__builtin_amdgcn_fmed3f(d[t2][i][0], 0.f, wr_[i][0]) + __builtin_amdgcn_fmed3f(d[t2][i][1], 0.f, wr_[i][1])) + (__builtin_amdgcn_fmed3f(d[t2][i][2], 0.f, wr_[i][2]) + __builtin_amdgcn_fmed3f(d[t2][i][3], 0.f, wr_[i][3]));
            const auto sa = __builtin_amdgcn_permlane16_swap(__float_as_uint(part[0]), __float_as_uint(part[1]), false, false);
            const auto sb = __builtin_amdgcn_permlane16_swap(__float_as_uint(part[2]), __float_as_uint(part[3]), false, false);
            const float sA = (__uint_as_float(sa[0]) + __uint_as_float(sa[1])) + 0.0f, sB = (__uint_as_float(sb[0]) + __uint_as_float(sb[1])) + 0.0f;
            const int key = tile * 16 + (lane & 15);
            const int binA = (int)fminf(fmaxf(fmaf(sA, 32.f, 448.f), 0.f), (float)(IDX_NBIN - 1)), binB = (int)fminf(fmaxf(fmaf(sB, 32.f, 448.f), 0.f), (float)(IDX_NBIN - 1));
            if (MODE == 0) {
                lds_add_u32(hist + qa * IDX_HW + (binA >> 1), (binA & 1) ? 65536u : 1u);
                lds_add_u32(hist + qb * IDX_HW + (binB >> 1), (binB & 1) ? 65536u : 1u);
            } else {
                const unsigned long long mA = __ballot(binA > bsa), mB = __ballot(binB > bsb);
                if (lane < 4) { const int q = wave * 8 + (((lane & 1) << 1) | (lane >> 1)); lds_store_u16(mask16 + q * 256 + tile, (unsigned)(mA >> (16 * lane)) & 0xffffu); }
                else if (lane < 8) { const int l = lane - 4; const int q = wave * 8 + 4 + (((l & 1) << 1) | (l >> 1)); lds_store_u16(mask16 + q * 256 + tile, (unsigned)(mB >> (16 * l)) & 0xffffu); }
                if (binA == bsa) { const int p = lds_add_rtn(sel + 128 + qa, 1); if (p < SEL_CAP) lds_store_u64(cand + qa * SEL_CAP + p, ((unsigned long long)sortkey(sA) << 32) | (unsigned)(4095 - key)); }
                if (binB == bsb) { const int p = lds_add_rtn(sel + 128 + qb, 1); if (p < SEL_CAP) lds_store_u64(cand + qb * SEL_CAP + p, ((unsigned long long)sortkey(sB) << 32) | (unsigned)(4095 - key)); }
            }
        }
        }
        asm volatile("s_waitcnt vmcnt(3) lgkmcnt(0)\n\ts_barrier" ::: "memory");
    }
    asm volatile("s_waitcnt vmcnt(0)" ::: "memory");
#undef IDX_DMA
}

__device__ __forceinline__ void idx_phase(const Args& a, LAS unsigned char* lds, int G, int bid) {
    int tid = threadIdx.x; asm volatile("" : "+v"(tid));
    const int lane = tid & 63, wave = tid >> 6;
    unsigned long long* MASK = (unsigned long long*)(a.ws + WS_MASK);
    for (int e = bid * NTHREADS + tid; e < NB * 4 * 4 * 64; e += G * NTHREADS) {
        const int q = e & 63, t = (e >> 6) & 3, c = (e >> 8) & 3, b = e >> 10;
        unsigned long long allsel = ~0ull; asm volatile("" : "+v"(allsel));
        if (t <= c) MASK[((size_t)(b * 64 + c) * 64 + t) * 64 + q] = allsel;
    }
    if (bid >= 240) return;
    const int b = bid / 30, j = bid % 30;
    LAS unsigned* hist = (LAS unsigned*)lds;
    LAS int* sel = (LAS int*)(lds + IDX_SEL);
    LAS unsigned* mask32 = (LAS unsigned*)lds;
    LAS unsigned long long* cand = (LAS unsigned long long*)(lds + 32768);
    for (int uu = 0; uu < 2; ++uu) {
        const int c = uu == 0 ? 63 - j : 4 + j;
        const size_t tok0 = (size_t)b * SEQ + c * 64;
        f16x8 af[4][2]; f32x4 wr_[4];
        {
            const h16* QI = (const h16*)(a.ws + WS_QI); const float* WI = (const float*)(a.ws + WS_WI);
#pragma unroll
            for (int i = 0; i < 4; ++i) {
                const size_t tq = tok0 + wave * 8 + 2 * i + ((lane & 15) >> 3);
                const h16* p = QI + tq * 512 + (lane & 7) * 64 + 8 * (lane >> 4);
                const float wrow = WI[tq * 8 + (lane & 7)];
                const f16x8 a0 = *(const f16x8*)p, a1 = *(const f16x8*)(p + 32);
#pragma unroll
                for (int j = 0; j < 8; ++j) { af[i][0][j] = (h16)((float)a0[j] * wrow); af[i][1][j] = (h16)((float)a1[j] * wrow); }
                const f32x4 wv = *(const f32x4*)(WI + (tok0 + wave * 8 + 2 * i + (lane >> 5)) * 8 + 4 * ((lane >> 4) & 1));
#pragma unroll
                for (int j = 0; j < 4; ++j) wr_[i][j] = wv[j] > 0.f ? INFINITY : -INFINITY;
            }
        }
        for (int e = tid; e < 64 * IDX_HW; e += NTHREADS) hist[e] = 0u;
        __syncthreads();
        idx_pass<0>(a, lds, b, c, af, wr_, wave, lane);
        __syncthreads();
        for (int ql = 0; ql < 8; ++ql) {
            const int q = wave * 8 + ql;
            unsigned cnt[14]; unsigned s = 0;
#pragma unroll
            for (int k = 0; k < 7; ++k) { const unsigned w = hist[q * IDX_HW + lane * 7 + k]; cnt[2 * k] = w & 0xffffu; cnt[2 * k + 1] = w >> 16; s += cnt[2 * k] + cnt[2 * k + 1]; }
            unsigned suf = s;
#pragma unroll
            for (int o = 1; o < 64; o <<= 1) { const unsigned t = __shfl_down(suf, o); if (lane + o < 64) suf += t; }
            const unsigned above = suf - s;
            if (suf >= 256u && above < 256u) {
                unsigned run = above; int bs = lane * 14; int need = 1;
#pragma unroll
                for (int k = 13; k >= 0; --k) { if (run < 256u && run + cnt[k] >= 256u) { bs = lane * 14 + k; need = 256 - (int)run; } run += cnt[k]; }
                sel[q] = bs; sel[64 + q] = need;
            }
        }
        __syncthreads();
        for (int e = tid; e < 8192; e += NTHREADS) mask32[e] = 0u;
        if (tid < 64) sel[128 + tid] = 0;
        __syncthreads();
        idx_pass<1>(a, lds, b, c, af, wr_, wave, lane);
        __syncthreads();
        for (int ql = 0; ql < 8; ++ql) {
            const int q = wave * 8 + ql; int n = sel[128 + q]; if (n > SEL_CAP) n = SEL_CAP; const int need = sel[64 + q];
            const unsigned long long c0 = lane < n ? cand[q * SEL_CAP + lane] : 0ull, c1 = (lane + 64) < n ? cand[q * SEL_CAP + lane + 64] : 0ull;
            int r0 = 0, r1 = 0;
            for (int i = 0; i < n; ++i) { const unsigned long long ci = cand[q * SEL_CAP + i]; r0 += (ci > c0) ? 1 : 0; r1 += (ci > c1) ? 1 : 0; }
            if (lane < n && r0 < need) { const int key = 4095 - (int)(c0 & 0xfffu); atomicOr((unsigned*)(mask32 + q * 128 + (key >> 5)), 1u << (key & 31)); }
            if (lane + 64 < n && r1 < need) { const int key = 4095 - (int)(c1 & 0xfffu); atomicOr((unsigned*)(mask32 + q * 128 + (key >> 5)), 1u << (key & 31)); }
        }
        __syncthreads();
        for (int e = tid; e < 64 * (c + 1); e += NTHREADS) {
            const int q = e & 63, t = e >> 6;
            MASK[((size_t)(b * 64 + c) * 64 + t) * 64 + q] = (unsigned long long)mask32[q * 128 + 2 * t] | ((unsigned long long)mask32[q * 128 + 2 * t + 1] << 32);
        }
        __syncthreads();
    }
}

__device__ __forceinline__ int crow(int r, int hi) { return (r & 3) + 8 * (r >> 2) + 4 * hi; }
#define ATT_THR 8.0f
constexpr int ATT_K = 0, ATT_V = 24576, ATT_M = 65536, ATT_Q = 69632, ATT_W = 102400;
__device__ __forceinline__ float bitsel_(int m, float a, unsigned cbits) { return __uint_as_float((__float_as_uint(a) & (unsigned)m) | (cbits & ~(unsigned)m)); }
__device__ __forceinline__ void att_tile(f32x16& s0, f32x16& s1, f32x16& n0, f32x16& n1, f16x8 (&pk)[4], f32x16& o0, f32x16& o1, float& lrun, float& mrun,
                                         const LAS unsigned char* qp, const LAS unsigned char* kn, const LAS unsigned char* vt, const unsigned long long mw, LAS float* wsf, const int hi, const int r32) {
    typedef short s16x8 __attribute__((ext_vector_type(8))); typedef short s16x4 __attribute__((ext_vector_type(4)));
    f16x8 kf[8];
#pragma unroll
    for (int d0 = 0; d0 < 2; ++d0) { kf[2 * d0] = *(const LAS f16x8*)(kn + d0 * 2048); kf[2 * d0 + 1] = *(const LAS f16x8*)(kn + d0 * 2048 + 512); }
    n0 = (f32x16){}; n1 = (f32x16){};
    f16x8 qr[4];
#pragma unroll
    for (int d0 = 0; d0 < 4; ++d0) qr[d0] = *(const LAS f16x8*)(qp + d0 * 1024);
    const int mlo = (int)(unsigned)(mw >> (4 * hi)), mhi = (int)(unsigned)(mw >> (32 + 4 * hi));
#define ATT_MF(j) do { if ((j) & 1) { n1 = __builtin_amdgcn_mfma_f32_32x32x16_f16(kf[j], qr[(j) >> 1], n1, 0, 0, 0); } \
                       else { n0 = __builtin_amdgcn_mfma_f32_32x32x16_f16(kf[j], qr[(j) >> 1], n0, 0, 0, 0); } } while (0)
#define ATT_MSK0(r) s0[r] = bitsel_(__builtin_amdgcn_sbfe(mlo, ((r) & 3) + 8 * ((r) >> 2), 1), s0[r], 0xff800000u)
#define ATT_MSK1(r) s1[r] = bitsel_(__builtin_amdgcn_sbfe(mhi, ((r) & 3) + 8 * ((r) >> 2), 1), s1[r], 0xff800000u)
    float mx;
    asm volatile("" : "+v"(kf[0]));
    ATT_MF(0);
    ATT_MSK0(0); ATT_MSK0(1); ATT_MSK0(2); ATT_MSK0(3); ATT_MSK0(4); ATT_MSK0(5); ATT_MSK0(6); ATT_MSK0(7);
    mx = fmaxf(fmaxf(s0[0], s0[1]), s0[2]); mx = fmaxf(fmaxf(mx, s0[3]), s0[4]); mx = fmaxf(fmaxf(mx, s0[5]), s0[6]); mx = fmaxf(mx, s0[7]);
    asm volatile("" : "+v"(kf[1]), "+v"(mx));
    ATT_MF(1);
    ATT_MSK0(8); ATT_MSK0(9); ATT_MSK0(10); ATT_MSK0(11); ATT_MSK0(12); ATT_MSK0(13); ATT_MSK0(14); ATT_MSK0(15);
    mx = fmaxf(fmaxf(mx, s0[8]), s0[9]); mx = fmaxf(fmaxf(mx, s0[10]), s0[11]); mx = fmaxf(fmaxf(mx, s0[12]), s0[13]); mx = fmaxf(fmaxf(mx, s0[14]), s0[15]);
    asm volatile("" : "+v"(kf[2]), "+v"(mx));
    ATT_MF(2);
    ATT_MSK1(0); ATT_MSK1(1); ATT_MSK1(2); ATT_MSK1(3); ATT_MSK1(4); ATT_MSK1(5); ATT_MSK1(6); ATT_MSK1(7);
    mx = fmaxf(fmaxf(mx, s1[0]), s1[1]); mx = fmaxf(fmaxf(mx, s1[2]), s1[3]); mx = fmaxf(fmaxf(mx, s1[4]), s1[5]); mx = fmaxf(fmaxf(mx, s1[6]), s1[7]);
    asm volatile("" : "+v"(kf[3]), "+v"(mx));
    ATT_MF(3);
    { const LAS unsigned char* kn2 = kn + 4096; asm volatile("" : "+v"(kn2), "+v"(mx));
#pragma unroll
      for (int d0 = 0; d0 < 2; ++d0) { kf[4 + 2 * d0] = *(const LAS f16x8*)(kn2 + d0 * 2048); kf[4 + 2 * d0 + 1] = *(const LAS f16x8*)(kn2 + d0 * 2048 + 512); } }
    ATT_MSK1(8); ATT_MSK1(9); ATT_MSK1(10); ATT_MSK1(11); ATT_MSK1(12); ATT_MSK1(13); ATT_MSK1(14); ATT_MSK1(15);
    mx = fmaxf(fmaxf(mx, s1[8]), s1[9]); mx = fmaxf(fmaxf(mx, s1[10]), s1[11]); mx = fmaxf(fmaxf(mx, s1[12]), s1[13]); mx = fmaxf(fmaxf(mx, s1[14]), s1[15]);
    asm volatile("" : "+v"(kf[4]), "+v"(mx));
    ATT_MF(4);
    { const auto rr = __builtin_amdgcn_permlane32_swap(__float_as_uint(mx), __float_as_uint(mx), false, false); mx = fmaxf(__uint_as_float(rr[0]), __uint_as_float(rr[1])); }
    const bool up = mx > mrun + ATT_THR;
    float mnew = up ? mx : mrun;
    const float alpha = __builtin_amdgcn_exp2f(mrun - mnew);
    mrun = mnew;
    asm volatile("" : "+v"(kf[5]), "+v"(mnew));
    ATT_MF(5);
    asm volatile("" : "+v"(kf[6]));
    ATT_MF(6);
    asm volatile("" : "+v"(kf[7]));
    ATT_MF(7);
#undef ATT_MF
#undef ATT_MSK0
#undef ATT_MSK1
    float rs = 0.f;
#define ATT_EX(S, r) do { S[r] = __builtin_amdgcn_exp2f(S[r] - mnew); rs += S[r]; } while (0)
#pragma unroll
    for (int ks = 0; ks < 4; ++ks) {
        s16x4 l0, h0, l1, h1;
        {
            unsigned vaddr = (unsigned)(size_t)(vt + ks * 1024);
            asm volatile("" : "+v"(vaddr), "+v"(rs));
            asm volatile("ds_read_b64_tr_b16 %0, %1" : "=v"(l0) : "v"(vaddr) : "memory");
            asm volatile("ds_read_b64_tr_b16 %0, %1 offset:512" : "=v"(h0) : "v"(vaddr) : "memory");
            asm volatile("ds_read_b64_tr_b16 %0, %1 offset:4096" : "=v"(l1) : "v"(vaddr) : "memory");
            asm volatile("ds_read_b64_tr_b16 %0, %1 offset:4608" : "=v"(h1) : "v"(vaddr) : "memory");
        }
        if (ks == 0) { ATT_EX(s0, 0); ATT_EX(s0, 1); ATT_EX(s0, 2); ATT_EX(s0, 3); ATT_EX(s0, 4); ATT_EX(s0, 5); ATT_EX(s0, 6); ATT_EX(s0, 7); }
        if (ks == 1) { ATT_EX(s0, 8); ATT_EX(s0, 9); ATT_EX(s0, 10); ATT_EX(s0, 11); ATT_EX(s0, 12); ATT_EX(s0, 13); ATT_EX(s0, 14); ATT_EX(s0, 15); }
        if (ks == 2) { ATT_EX(s1, 0); ATT_EX(s1, 1); ATT_EX(s1, 2); ATT_EX(s1, 3); ATT_EX(s1, 4); ATT_EX(s1, 5); ATT_EX(s1, 6); ATT_EX(s1, 7); }
        if (ks == 3) { ATT_EX(s1, 8); ATT_EX(s1, 9); ATT_EX(s1, 10); ATT_EX(s1, 11); ATT_EX(s1, 12); ATT_EX(s1, 13); ATT_EX(s1, 14); ATT_EX(s1, 15); }
        asm volatile("s_waitcnt lgkmcnt(0)" : "+v"(rs) :: "memory"); __builtin_amdgcn_sched_barrier(0);
        {
            const f16x8 v0 = __builtin_bit_cast(f16x8, (s16x8){l0[0], l0[1], l0[2], l0[3], h0[0], h0[1], h0[2], h0[3]}), v1 = __builtin_bit_cast(f16x8, (s16x8){l1[0], l1[1], l1[2], l1[3], h1[0], h1[1], h1[2], h1[3]});
            o0 = __builtin_amdgcn_mfma_f32_32x32x16_f16(pk[ks], v0, o0, 0, 0, 0);
            o1 = __builtin_amdgcn_mfma_f32_32x32x16_f16(pk[ks], v1, o1, 0, 0, 0);
            asm volatile("" : "+v"(mnew));
        }
#pragma unroll
        for (int j = 0; j < 8; ++j) pk[ks][j] = (h16)((ks < 2) ? s0[8 * (ks & 1) + j] : s1[8 * (ks & 1) + j]);
    }
#undef ATT_EX
    if (__any(up)) {
        if (hi == 0) wsf[r32] = alpha;
#pragma unroll
        for (int k = 0; k < 4; ++k) { const f32x4 al = *(const LAS f32x4*)(wsf + 8 * k + 4 * hi);
#pragma unroll
            for (int j = 0; j < 4; ++j) { o0[4 * k + j] *= al[j]; o1[4 * k + j] *= al[j]; } }
    }
    lrun = lrun * alpha + rs;
}

__device__ __forceinline__ void attn_phase(const Args& a, LAS unsigned char* lds, int G, int bid) {
    int tid = threadIdx.x; asm volatile("" : "+v"(tid));
    const int lane = tid & 63, wid = __builtin_amdgcn_readfirstlane(tid >> 6), r32 = lane & 31, hi = lane >> 5;
    const h16* Q = (const h16*)(a.ws + WS_Q); const h16* KB = (const h16*)(a.ws + WS_KB); const h16* VB = (const h16*)(a.ws + WS_VB);
    const h16* ZS = (const h16*)(a.ws + WS_ZS); h16* AO = (h16*)(a.ws + WS_AO);
    const unsigned long long* MASK = (const unsigned long long*)(a.ws + WS_MASK);
    LAS float* wsf = (LAS float*)(lds + ATT_W) + wid * 64;
    if (bid >= 256) return;
    const int bg = bid >> 3, s = bid & 7, b = bg >> 2, g = bg & 3;
#define ATT_WAITBAR(NA, NB) do { if (wid < 2) asm volatile("s_waitcnt vmcnt(" #NA ") lgkmcnt(0)\n\ts_barrier" ::: "memory"); else asm volatile("s_waitcnt vmcnt(" #NB ") lgkmcnt(0)\n\ts_barrier" ::: "memory"); } while (0)
    for (int ui = 0; ui < 8; ++ui) {
        const int k2 = ui >> 1, base = 16 * k2;
        const int c = (ui & 1) ? base + 15 - s : base + s;
        const size_t tok0 = (size_t)b * SEQ + c * 64;
        const int hh = g * 4 + (wid >> 1), qbase = 32 * (wid & 1);
        const size_t tq = tok0 + qbase + r32;
        f32x16 o0 = {}, o1 = {};
        float mrun = -1e30f, lrun = 0.f;
        const h16* ksrc = KB + ((size_t)b * SEQ + lane) * 256 + g * 64 + wid * 8;
        const h16* vsrc = VB + ((size_t)b * SEQ + 16 * (wid & 3) + (lane >> 2)) * 256 + g * 64 + (wid >> 2) * 32 + (lane & 3) * 8;
        const unsigned* msrc = (const unsigned*)(MASK + ((size_t)(b * 64 + c) * 64) * 64) + wid * 64 + lane;
        const int nT = c + 1;
        const LAS unsigned char* kb = lds + ATT_K + hi * 1024 + r32 * 16;
        const LAS unsigned char* vp = lds + ATT_V + ((lane >> 4) & 1) * 32 + (lane & 3) * 8 + (4 * hi + ((lane & 15) >> 2)) * 64;
        const LAS unsigned char* mp = lds + ATT_M + (qbase + r32) * 8;
        LAS unsigned char* qs = lds + ATT_Q + wid * 4096;
        const LAS unsigned char* qp = qs + lane * 16;
        const unsigned dmaoff = (unsigned)wid * 1024u;
#define ATT_DMA(J) do { const int j_ = (J); \
            __builtin_amdgcn_global_load_lds((const unsigned*)(ksrc + (size_t)j_ * 64 * 256), (LAS unsigned*)(lds + ATT_K + (j_ % 3) * 8192 + dmaoff), 16, 0, 0); \
            __builtin_amdgcn_global_load_lds((const unsigned*)(vsrc + (size_t)j_ * 64 * 256), (LAS unsigned*)(lds + ATT_V + (j_ % 5) * 8192 + dmaoff), 16, 0, 0); \
            if (wid < 2) __builtin_amdgcn_global_load_lds(msrc + (size_t)j_ * 128, (LAS unsigned*)(lds + ATT_M + (j_ & 7) * 512 + wid * 256), 4, 0, 0); } while (0)
        {
            f16x8 qv[4];
#pragma unroll
            for (int d0 = 0; d0 < 4; ++d0) qv[d0] = *(const f16x8*)(Q + tq * 1024 + hh * 64 + d0 * 16 + hi * 8);
#pragma unroll
            for (int d0 = 0; d0 < 4; ++d0) *(LAS f16x8*)(qs + d0 * 1024 + lane * 16) = qv[d0];
        }
        *(LAS f16x8*)(lds + ATT_V + 4 * 8192 + wid * 1024 + lane * 16) = (f16x8){};
        ATT_DMA(0); ATT_DMA(1); ATT_DMA(2);
        ATT_WAITBAR(5, 3);
        f32x16 sa0 = {}, sa1 = {}, sb0 = {}, sb1 = {};
#pragma unroll
        for (int d0 = 0; d0 < 4; ++d0) {
            const f16x8 k0 = *(const LAS f16x8*)(kb + d0 * 2048), k1 = *(const LAS f16x8*)(kb + d0 * 2048 + 512), qf = *(const LAS f16x8*)(qp + d0 * 1024);
            sa0 = __builtin_amdgcn_mfma_f32_32x32x16_f16(k0, qf, sa0, 0, 0, 0);
            sa1 = __builtin_amdgcn_mfma_f32_32x32x16_f16(k1, qf, sa1, 0, 0, 0);
        }
        f16x8 pk[4];
#pragma unroll
        for (int k = 0; k < 4; ++k) pk[k] = (f16x8){};
        asm volatile("s_waitcnt lgkmcnt(0)\n\ts_barrier" ::: "memory");
#define ATT_STEP(SC0, SC1, SN0, SN1, T) do { const int t_ = (T); \
            ATT_DMA(t_ + 3); \
            const unsigned long long mw_ = *(const LAS unsigned long long*)(mp + (t_ & 7) * 512); \
            att_tile(SC0, SC1, SN0, SN1, pk, o0, o1, lrun, mrun, qp, kb + ((t_ + 1) % 3) * 8192, vp + ((t_ + 4) % 5) * 8192, mw_, wsf, hi, r32); \
            ATT_WAITBAR(5, 3); } while (0)
        int t = 0;
        for (; t + 1 < nT; t += 2) { ATT_STEP(sa0, sa1, sb0, sb1, t); ATT_STEP(sb0, sb1, sa0, sa1, t + 1); }
        if (t < nT) ATT_STEP(sa0, sa1, sb0, sb1, t);
#undef ATT_STEP
#undef ATT_DMA
        asm volatile("s_waitcnt vmcnt(0)" ::: "memory");
        {
            typedef short s16x8 __attribute__((ext_vector_type(8)));
            const LAS unsigned char* vt = vp + ((nT - 1) % 5) * 8192;
#pragma unroll
            for (int ks = 0; ks < 4; ++ks) {
                const v4i16_t l0 = __builtin_amdgcn_ds_read_tr16_b64_v4i16((LAS v4i16_t*)(vt + ks * 1024)), h0 = __builtin_amdgcn_ds_read_tr16_b64_v4i16((LAS v4i16_t*)(vt + ks * 1024 + 512));
                const v4i16_t l1 = __builtin_amdgcn_ds_read_tr16_b64_v4i16((LAS v4i16_t*)(vt + 4096 + ks * 1024)), h1 = __builtin_amdgcn_ds_read_tr16_b64_v4i16((LAS v4i16_t*)(vt + 4096 + ks * 1024 + 512));
                const f16x8 v0 = __builtin_bit_cast(f16x8, (s16x8){l0[0], l0[1], l0[2], l0[3], h0[0], h0[1], h0[2], h0[3]}), v1 = __builtin_bit_cast(f16x8, (s16x8){l1[0], l1[1], l1[2], l1[3], h1[0], h1[1], h1[2], h1[3]});
                o0 = __builtin_amdgcn_mfma_f32_32x32x16_f16(pk[ks], v0, o0, 0, 0, 0);
                o1 = __builtin_amdgcn_mfma_f32_32x32x16_f16(pk[ks], v1, o1, 0, 0, 0);
            }
        }
        lrun += __shfl_xor(lrun, 32);
        if (hi == 0) wsf[r32] = __builtin_amdgcn_rcpf(lrun);
        const size_t orow0 = tok0 + qbase;
#pragma unroll
        for (int r = 0; r < 16; ++r) {
            const int q = crow(r, hi); const float li = wsf[q];
            const size_t off = (orow0 + q) * 1024 + hh * 64 + r32;
            AO[off] = (h16)(o0[r] * li * (float)ZS[off]);
            AO[off + 32] = (h16)(o1[r] * li * (float)ZS[off + 32]);
        }
        __syncthreads();
    }
#undef ATT_WAITBAR
}

__device__ __forceinline__ void final_phase(const Args& a, int G, int bid) {
    int tid = threadIdx.x; asm volatile("" : "+v"(tid));
    const int lane = tid & 63, wave = tid >> 6;
    const float* rss = (const float*)(a.ws + WS_RSS2);
    for (int row = bid * 8 + wave; row < MTOK; row += G * 8) {
        const float rs = __builtin_amdgcn_rsqf(rss[row] * (1.0f / 1024.0f) + NORM_EPS);
        f32x4* p = (f32x4*)(a.out + (size_t)row * 1024) + lane;
#pragma unroll
        for (int j = 0; j < 4; ++j) { const f32x4 g = *((const f32x4*)a.final_g + lane + 64 * j); p[64 * j] = p[64 * j] * rs * g; }
    }
}

#define XB_TMO      128
#define XB_XCNT(j)  (256  + 64 * (j))
#define XB_XSUB(j)  (1280 + 64 * (j))
#define XB_XGEN(j)  (2304 + 64 * (j))
#define XB_TOP      3328
#define XB_TOPGEN   3392
#define XCD_BAR_WORDS 3456
#define XB_SPIN_CAP (1u << 18)
__device__ __forceinline__ unsigned xb_ld(unsigned* p)              { return __hip_atomic_load(p, __ATOMIC_RELAXED, __HIP_MEMORY_SCOPE_AGENT); }
__device__ __forceinline__ unsigned xb_add(unsigned* p, unsigned v) { return __hip_atomic_fetch_add(p, v, __ATOMIC_RELAXED, __HIP_MEMORY_SCOPE_AGENT); }
__device__ __forceinline__ unsigned xb_xcc_id() { return (unsigned)__builtin_amdgcn_s_getreg((3 << 11) | 20) & 0xFu; }
#define XB_SPIN(cond, bar) do { unsigned _sp = 0; while (cond) { __builtin_amdgcn_s_sleep(1); \
    if ((++_sp & 255u) == 0u) { if (xb_ld(&(bar)[XB_TMO])) break; if (_sp > XB_SPIN_CAP) { atomicAdd(&(bar)[XB_TMO], 1u); break; } } } } while (0)
struct XcdBarrier { unsigned* bar; unsigned x; volatile LAS unsigned* st; };
__device__ __forceinline__ XcdBarrier xcd_barrier_post(unsigned* bar, volatile LAS unsigned* st) {
    XcdBarrier b; b.bar = bar; b.x = xb_xcc_id(); b.st = st;
    if (threadIdx.x == 0) (void)xb_add(&bar[XB_XCNT(b.x)], 1u);
    return b;
}
__device__ __forceinline__ void xcd_barrier_complete(unsigned* bar, unsigned x, unsigned& nloc, unsigned& nx) {
    const unsigned G = gridDim.x * gridDim.y * gridDim.z;
    unsigned sum, cnt, mine, sp = 0u;
    for (;;) {
        sum = 0u; cnt = 0u; mine = 0u;
#pragma unroll
        for (unsigned j = 0; j < 16; ++j) { const unsigned c = xb_ld(&bar[XB_XCNT(j)]); sum += c; cnt += (c > 0u) ? 1u : 0u; mine = (j == x) ? c : mine; }
        if (sum == G) break;
        __builtin_amdgcn_s_sleep(1);
        if ((++sp & 255u) == 0u) { if (xb_ld(&bar[XB_TMO])) break; if (sp > XB_SPIN_CAP) { atomicAdd(&bar[XB_TMO], 1u); break; } }
    }
    nloc = mine > 0u ? mine : 1u; nx = cnt > 0u ? cnt : 1u;
}
__device__ __forceinline__ void xcd_barrier(const XcdBarrier& b) {
    asm volatile("s_waitcnt vmcnt(0)" ::: "memory");
    __syncthreads();
    if (threadIdx.x == 0) {
        unsigned* bar = b.bar;
        __builtin_amdgcn_s_waitcnt(0);
        unsigned nloc = b.st[0], nx = b.st[1];
        if (nloc == 0u) { xcd_barrier_complete(bar, b.x, nloc, nx); b.st[0] = nloc; b.st[1] = nx; }
        const unsigned old = xb_add(&bar[XB_XSUB(b.x)], 1u);
        const unsigned gen = old / nloc;
        if (old + 1u == (gen + 1u) * nloc) {
            __builtin_amdgcn_fence(__ATOMIC_RELEASE, "agent");
            asm volatile("s_waitcnt vmcnt(0)" ::: "memory");
            const unsigned og = xb_add(&bar[XB_TOP], 1u);
            const unsigned tg = og / nx;
            if (og + 1u == (tg + 1u) * nx) xb_add(&bar[XB_TOPGEN], 1u);
            else XB_SPIN(xb_ld(&bar[XB_TOPGEN]) == tg, bar);
            __builtin_amdgcn_fence(__ATOMIC_ACQUIRE, "agent");
            xb_add(&bar[XB_XGEN(b.x)], 1u);
            asm volatile("s_waitcnt vmcnt(0)" ::: "memory");
        } else {
            XB_SPIN(xb_ld(&bar[XB_XGEN(b.x)]) == gen, bar);
            __builtin_amdgcn_fence(__ATOMIC_ACQUIRE, "agent");
            asm volatile("s_waitcnt vmcnt(0)" ::: "memory");
        }
    }
    __syncthreads();
}

__global__ void __launch_bounds__(NTHREADS, 2) mega(Args a) {
    extern __shared__ __attribute__((aligned(16))) unsigned char lds_raw[];
    LAS unsigned char* lds = (LAS unsigned char*)lds_raw;
    const int G = gridDim.x, bid = blockIdx.x;
    unsigned char* ws = a.ws;
#if ONE_LAUNCH
    volatile LAS unsigned* bst = (volatile LAS unsigned*)(lds + LDS_BYTES - 64);
    if (threadIdx.x < 2) bst[threadIdx.x] = 0u;
    __syncthreads();
    const XcdBarrier xbar = xcd_barrier_post((unsigned*)(ws + WS_BAR), bst);
#define SEAM() xcd_barrier(xbar)
#else
#define SEAM() do {} while (0)
#endif
    for (int ph = a.ph_lo; ph < a.ph_hi; ++ph) {
      for (int rep = 0; rep < (((PH_REP >> ph) & 1) ? 2 : 1); ++rep) {
        if (rep) { SEAM(); }
        GemmP g{nullptr, nullptr, 1024, 1024, 1024, 0, 0, MTOK / 256, 4, 0}; int mode = -1;
        if (ph == 1) { g.A = (const char*)(ws + WS_XN); g.Bt = (const char*)(ws + WS_WE_IN); g.nN = NE_IN / 256; mode = E_EVEN_IN; }
        else if (ph == 2) { g = GemmP{(const char*)(ws + WS_UA), (const char*)(ws + WS_MS), 384, 256, 256, 2048L * 384 * 2, 256L * 256 * 2, 8, 1, 32}; mode = E_SEND; }
        else if (ph == 4) { g = GemmP{(const char*)(ws + WS_UA), (const char*)(ws + WS_MY), 384, 384, 384, 2048L * 384 * 2, 256L * 384 * 2, 8, 1, 32}; mode = E_Y; }
        else if (ph == 5) { g = GemmP{(const char*)(ws + WS_GG), (const char*)(ws + WS_WGLU), 512, 512, 512, 0, 0, MTOK / 256, 2, 0}; mode = E_GLU; }
        else if (ph == 6) { g.A = (const char*)(ws + WS_YCAT); g.Bt = (const char*)(ws + WS_WE_OUT); mode = E_OUT_EVEN; }
        else if (ph == 7) { g.A = (const char*)(ws + WS_XN); g.Bt = (const char*)(ws + WS_WO_IN); g.nN = NO_PAD / 256; mode = E_ODD_IN; }
        else if (ph == 10) { g.A = (const char*)(ws + WS_AO); g.Bt = (const char*)(ws + WS_WO_OUT); mode = E_OUT_ODD; }
#ifdef FIXED_MODE
        if (mode >= 0 && ((PH_EN >> ph) & 1)) gemm_phase(lds, g, FIXED_MODE, a, G, bid);
#else
        if (mode >= 0 && ((PH_EN >> ph) & 1)) gemm_phase(lds, g, mode, a, G, bid);
#endif
        if (ph == 0 && (PH_EN & 1)) p0_prologue(a, lds, G, bid);
        else if (ph == 1 && (PH_EN & 2)) s5_fill(a, G, bid);
        else if (ph == 2 && (PH_EN & 4)) { asm volatile("s_waitcnt vmcnt(0)" ::: "memory"); __syncthreads(); scan_phase(a, lds, G, bid); __syncthreads(); conv_phase(a, lds, G, bid); }
        else if (ph == 8 && (PH_EN & 0x100)) idx_phase(a, lds, G, bid);
        else if (ph == 9 && (PH_EN & 0x200)) attn_phase(a, lds, G, bid);

      }
        if (ph + 1 < a.ph_hi && ph != 3 && ph < 10) { SEAM(); }
#ifdef XSYNC
        if (ph == 5) { for (int xs = 0; xs < XSYNC; ++xs) { SEAM(); } }
#endif
    }
}

extern "C" void kernel_launch(void* const* d_in, const int* in_sizes, int n_in, void* d_out, int out_size, void* d_ws, size_t ws_size, hipStream_t stream) {
    static int grid = 0;
    if (grid == 0) {
        if (n_in != 21 || out_size != MTOK * DM || ws_size < WS_END) { fprintf(stderr, "kernel_launch: unexpected problem (n_in %d, out %d, ws %zu)\n", n_in, out_size, ws_size); grid = -1; return; }
        if (hipFuncSetAttribute((const void*)mega, hipFuncAttributeMaxDynamicSharedMemorySize, LDS_BYTES) != hipSuccess) { fprintf(stderr, "kernel_launch: hipFuncSetAttribute failed\n"); grid = -1; return; }
        int dev = 0, cus = 0, per_cu = 0;
        (void)hipGetDevice(&dev); (void)hipDeviceGetAttribute(&cus, hipDeviceAttributeMultiprocessorCount, dev);
        (void)hipOccupancyMaxActiveBlocksPerMultiprocessor(&per_cu, (const void*)mega, NTHREADS, LDS_BYTES);
        if (per_cu < 1 || cus != 256) { fprintf(stderr, "kernel_launch: occupancy %d blocks/CU, %d CUs: this kernel needs 1 block on each of 256 CUs\n", per_cu, cus); grid = -1; return; }
        grid = 256;
    }
    if (grid < 0) return;
    (void)hipMemsetAsync((char*)d_ws, 0, CTL_ZERO_BYTES, stream);
    Args a{};
    const float** ap = (const float**)&a;
    for (int i = 0; i < 21; ++i) ap[i] = (const float*)d_in[i];
    a.out = (float*)d_out; a.ws = (unsigned char*)d_ws;
#if ONE_LAUNCH
    a.ph_lo = 0; a.ph_hi = NPHASE;
    void* args[] = {&a};
    hipError_t e = hipLaunchCooperativeKernel((const void*)mega, dim3(grid), dim3(NTHREADS), args, LDS_BYTES, stream);
    if (e != hipSuccess) fprintf(stderr, "cooperative launch failed: %s\n", hipGetErrorString(e));
#else
    for (int ph = 0; ph < NPHASE; ++ph) { a.ph_lo = ph; a.ph_hi = ph + 1; hipLaunchKernelGGL(mega, dim3(grid), dim3(NTHREADS), LDS_BYTES, stream, a); }
#endif
}
```

```cpp
#include <hip/hip_runtime.h>
#include <hip/hip_cooperative_groups.h>
#include <cstdio>
#include <cstdint>
namespace cg = cooperative_groups;

#define LAS __attribute__((address_space(3)))
typedef _Float16 h16;
typedef _Float16 f16x8 __attribute__((ext_vector_type(8)));
typedef _Float16 f16x4 __attribute__((ext_vector_type(4)));
typedef _Float16 f16x2 __attribute__((ext_vector_type(2)));
typedef float f32x2 __attribute__((ext_vector_type(2)));
typedef float f32x4 __attribute__((ext_vector_type(4)));
typedef float f32x16 __attribute__((ext_vector_type(16)));
typedef unsigned u32x4 __attribute__((ext_vector_type(4)));
typedef short v4i16_t __attribute__((ext_vector_type(4)));

#ifndef PH_EN
#define PH_EN 0xFFF
#endif
#ifndef PH_REP
#define PH_REP 0
#endif
#ifndef ONE_LAUNCH
#define ONE_LAUNCH 1
#endif

constexpr int NB = 8, SEQ = 4096, DM = 1024, MTOK = NB * SEQ;
constexpr int NE_IN = 2560, NO_IN = 3144, NO_PAD = 3328;
constexpr float NORM_EPS = 1e-6f;
constexpr int NTHREADS = 512;
constexpr int LDS_BYTES = 163840;
constexpr int NPHASE = 12;

constexpr size_t MiB = 1u << 20;
constexpr size_t WS_RSS1 = 0, WS_RSS2 = 128 * 1024, WS_BAR = 256 * 1024, WS_PCNT = 272 * 1024, CTL_ZERO_BYTES = 272 * 1024 + 32 * 1024;
constexpr size_t WS_ROPE = 1 * MiB;
constexpr size_t WS_ABT = 1 * MiB + 512 * 1024;
constexpr size_t WS_WE_IN = 2 * MiB;
constexpr size_t WS_WGLU = 7 * MiB;
constexpr size_t WS_WE_OUT = 8 * MiB;
constexpr size_t WS_WO_IN = 10 * MiB;
constexpr size_t WS_WO_OUT = 17 * MiB;
constexpr size_t WS_MY = 19 * MiB;
constexpr size_t WS_MS = 25 * MiB;
constexpr size_t WS_S5T = 29 * MiB;
constexpr size_t WS_XN = 32 * MiB;
constexpr size_t WS_UA = 96 * MiB;
constexpr size_t WS_SEND = 144 * MiB;
constexpr size_t WS_ZA = 176 * MiB;
constexpr size_t WS_HB = 208 * MiB;
constexpr size_t WS_ZB = 240 * MiB;
constexpr size_t WS_GG = 272 * MiB;
constexpr size_t WS_YCAT = 304 * MiB;
constexpr size_t WS_Q = 96 * MiB;
constexpr size_t WS_ZS = 160 * MiB;
constexpr size_t WS_KB = 224 * MiB;
constexpr size_t WS_VB = 240 * MiB;
constexpr size_t WS_QI = 256 * MiB;
constexpr size_t WS_KI = 288 * MiB;
constexpr size_t WS_WI = 292 * MiB;
constexpr size_t WS_MASK = 296 * MiB;
constexpr size_t WS_AO = 312 * MiB;
constexpr size_t WS_END = 376 * MiB;

struct Args {
    const float* x; const float* norm_g; const float* e_w_in; const float* e_lam_re; const float* e_lam_im; const float* e_log_step;
    const float* e_b_re; const float* e_b_im; const float* e_c_re; const float* e_c_im; const float* e_d_skip; const float* e_w_glu; const float* e_b_glu;
    const float* e_conv_w; const float* e_conv_b; const float* e_ln_g; const float* e_ln_b; const float* e_w_out; const float* o_w_in; const float* o_w_out; const float* final_g;
    float* out; unsigned char* ws; int ph_lo, ph_hi;
};

__device__ __forceinline__ float wave_sum(float v) {
#pragma unroll
    for (int o = 1; o < 64; o <<= 1) v += __shfl_xor(v, o);
    return v;
}
__device__ __forceinline__ float sigmoidf_(float x) { return __builtin_amdgcn_rcpf(1.0f + __builtin_amdgcn_exp2f(-1.4426950408889634f * x)); }
__device__ __forceinline__ float siluf_(float x) { return x * sigmoidf_(x); }
__device__ __forceinline__ float gelu_tanh(float x) {
    const float u2 = 1.5957691216057308f * (x + 0.044715f * x * x * x);
    return x * sigmoidf_(u2);
}
__device__ __forceinline__ f16x8 cvt8(const f32x4 a, const f32x4 b) {
    f16x8 o; o[0] = (h16)a[0]; o[1] = (h16)a[1]; o[2] = (h16)a[2]; o[3] = (h16)a[3]; o[4] = (h16)b[0]; o[5] = (h16)b[1]; o[6] = (h16)b[2]; o[7] = (h16)b[3]; return o;
}

constexpr int BM = 256, BK = 64, HALF = 128, HTB = HALF * BK * 2, STAGE_BYTES = 8 * HTB;
__device__ __forceinline__ int lds_byte(int r, int c) { const int st = (r >> 4) * 2 + (c >> 5), rr = r & 15, cc = c & 31, ob = rr * 64 + cc * 2; return st * 1024 + (ob ^ (((ob >> 9) & 1) << 5)); }
__device__ __forceinline__ void stage_rc(int b, int& R, int& C) { const int st = b / 1024, sb = b % 1024, swz = sb ^ (((sb >> 9) & 1) << 5); R = (st >> 1) * 16 + swz / 64; C = (st & 1) * 32 + (swz % 64) / 2; }
__device__ __forceinline__ int perm32(int rho) { const int n = rho >> 4, i = rho & 15; return 8 * (i >> 2) + 4 * n + (i & 3); }

struct Unit { int pm, pn, grp; };
struct GemmP { const char* A; const char* Bt; int lda, ldb, K; long gsA, gsB; int nM, nN, ngrp; };

__device__ __forceinline__ bool unit_next(const GemmP& g, int i, int G, int c, Unit& u) {
    const long Lx = (long)i * G + c;
    const bool grouped = g.ngrp > 0;
    const int nwg = grouped ? g.nM * g.ngrp : g.nM * g.nN;
    const bool ok = Lx < (long)nwg;
    const int L0 = ok ? (int)Lx : 0;
    const int gpm = L0 % g.nM, ggrp = L0 / g.nM;
    int wgid = L0; { const int q = nwg / 8, r = nwg % 8, xcd = wgid % 8, off = wgid / 8; wgid = (xcd < r ? xcd * (q + 1) : r * (q + 1) + (xcd - r) * q) + off; }
    const int nig = 8 * g.nN, gid = wgid / nig, fm = gid * 8, gsz = (g.nM - fm) < 8 ? (g.nM - fm) : 8;
    const int dpm = fm + ((wgid % nig) % gsz), dpn = (wgid % nig) / gsz;
    Unit r; r.pm = grouped ? gpm : dpm; r.pn = grouped ? 0 : dpn; r.grp = grouped ? ggrp : 0;
    u = r; return ok;
}

enum EpiMode { E_EVEN_IN = 0, E_SEND = 1, E_Y = 2, E_GLU = 3, E_OUT_EVEN = 4, E_ODD_IN = 5, E_OUT_ODD = 6 };

__device__ __forceinline__ void epilogue(const int mode, const Args& a, const f32x4 (&acc)[2][2][4][2], const Unit& u, int wr, int wc, int fr, int fq) {
    asm volatile("" : "+v"(fr), "+v"(fq));
    unsigned char* ws = a.ws;
    const int colw = 32 * wc + 8 * fq;
    if (mode == E_EVEN_IN) {
        const int pn = u.pn;
        if (pn >= 4 && pn < 8) {
            h16* HB = (h16*)(ws + WS_HB);
#pragma unroll
            for (int ai = 0; ai < 2; ++ai)
#pragma unroll
                for (int m = 0; m < 4; ++m) {
                    const int row = u.pm * BM + ai * HALF + wr * 64 + m * 16 + fr;
                    f32x4 o0, o1;
#pragma unroll
                    for (int j = 0; j < 4; ++j) { o0[j] = acc[ai][0][m][0][j] * sigmoidf_(acc[ai][1][m][0][j]); o1[j] = acc[ai][0][m][1][j] * sigmoidf_(acc[ai][1][m][1][j]); }
                    *(f16x8*)(HB + (size_t)row * 512 + (pn - 4) * 128 + colw) = cvt8(o0, o1);
                }
        } else {
#pragma unroll
            for (int ai = 0; ai < 2; ++ai)
#pragma unroll
                for (int m = 0; m < 4; ++m) {
                    const int row = u.pm * BM + ai * HALF + wr * 64 + m * 16 + fr;
#pragma unroll
                    for (int bj = 0; bj < 2; ++bj) {
                        const int col = pn * BM + bj * HALF + colw;
                        f32x4 v0 = acc[ai][bj][m][0], v1 = acc[ai][bj][m][1];
                        if (pn < 2) {
                            const int g = col >> 4;
                            h16* p = (h16*)(ws + WS_UA) + (size_t)g * (2048 * 384) + (size_t)(row >> 4) * 384 + (row & 15) * 16 + (col & 15);
                            *(f16x8*)p = cvt8(v0, v1);
                        } else {
#pragma unroll
                            for (int j = 0; j < 4; ++j) { v0[j] = siluf_(v0[j]); v1[j] = siluf_(v1[j]); }
                            if (pn < 4) *(f16x8*)((h16*)(ws + WS_ZA) + (size_t)row * 512 + (col - 512)) = cvt8(v0, v1);
                            else        *(f16x8*)((h16*)(ws + WS_ZB) + (size_t)row * 512 + (col - 2048)) = cvt8(v0, v1);
                        }
                    }
                }
        }
    } else if (mode == E_SEND) {
        float* SE = (float*)(ws + WS_SEND) + (size_t)u.grp * (2048 * 128);
#pragma unroll
        for (int ai = 0; ai < 2; ++ai)
#pragma unroll
            for (int m = 0; m < 4; ++m) {
                const int row = u.pm * BM + ai * HALF + wr * 64 + m * 16 + fr;
                float* p = SE + (size_t)row * 128 + colw;
                *(f32x4*)p = acc[ai][0][m][0]; *(f32x4*)(p + 4) = acc[ai][0][m][1];
            }
    } else if (mode == E_Y) {
        const h16* UA = (const h16*)(ws + WS_UA) + (size_t)u.grp * (2048 * 384);
        h16* GG = (h16*)(ws + WS_GG);
#pragma unroll
        for (int bj = 0; bj < 2; ++bj) {
            const int col = bj * HALF + colw, t = col >> 4, c0 = col & 15;
            const f32x4 d0 = *(const f32x4*)(a.e_d_skip + u.grp * 16 + c0), d1 = *(const f32x4*)(a.e_d_skip + u.grp * 16 + c0 + 4);
#pragma unroll
            for (int ai = 0; ai < 2; ++ai)
#pragma unroll
                for (int m = 0; m < 4; ++m) {
                    const int row = u.pm * BM + ai * HALF + wr * 64 + m * 16 + fr;
                    const f16x8 uu = *(const f16x8*)(UA + (size_t)row * 384 + col);
                    f32x4 o0, o1;
#pragma unroll
                    for (int j = 0; j < 4; ++j) { o0[j] = gelu_tanh(acc[ai][bj][m][0][j] + (float)uu[j] * d0[j]); o1[j] = gelu_tanh(acc[ai][bj][m][1][j] + (float)uu[4 + j] * d1[j]); }
                    *(f16x8*)(GG + ((size_t)row * 16 + t) * 512 + u.grp * 16 + c0) = cvt8(o0, o1);
                }
        }
    } else if (mode == E_GLU) {
        const h16* GG = (const h16*)(ws + WS_GG); const h16* ZA = (const h16*)(ws + WS_ZA); h16* YC = (h16*)(ws + WS_YCAT);
#pragma unroll
        for (int bj = 0; bj < 2; ++bj) {
            const int col = u.pn * BM + bj * HALF + colw;
            const f32x4 b0 = *(const f32x4*)(a.e_b_glu + col), b1 = *(const f32x4*)(a.e_b_glu + col + 4);
#pragma unroll
            for (int ai = 0; ai < 2; ++ai)
#pragma unroll
                for (int m = 0; m < 4; ++m) {
                    const int row = u.pm * BM + ai * HALF + wr * 64 + m * 16 + fr;
                    const f16x8 gg = *(const f16x8*)(GG + (size_t)row * 512 + col), za = *(const f16x8*)(ZA + (size_t)row * 512 + col);
                    f32x4 o0, o1;
#pragma unroll
                    for (int j = 0; j < 4; ++j) { o0[j] = (float)gg[j] * sigmoidf_(acc[ai][bj][m][0][j] + b0[j]) * (float)za[j]; o1[j] = (float)gg[4 + j] * sigmoidf_(acc[ai][bj][m][1][j] + b1[j]) * (float)za[4 + j]; }
                    *(f16x8*)(YC + (size_t)row * 1024 + col) = cvt8(o0, o1);
                }
        }
    } else if (mode == E_OUT_ODD) {
        float* rss = (float*)(ws + WS_RSS2);
        unsigned* pcnt = (unsigned*)(ws + WS_PCNT) + u.pm * 64;
#pragma unroll
        for (int ai = 0; ai < 2; ++ai)
#pragma unroll
            for (int m = 0; m < 4; ++m) {
                const int row = u.pm * BM + ai * HALF + wr * 64 + m * 16 + fr;
                float ss = 0.f;
#pragma unroll
                for (int bj = 0; bj < 2; ++bj) {
                    const size_t off = (size_t)row * 1024 + u.pn * BM + bj * HALF + colw;
                    const f32x4 h0 = acc[ai][bj][m][0] + *(const f32x4*)(a.out + off), h1 = acc[ai][bj][m][1] + *(const f32x4*)(a.out + off + 4);
#pragma unroll
                    for (int j = 0; j < 4; ++j) ss += h0[j] * h0[j] + h1[j] * h1[j];
                }
                ss += __shfl_xor(ss, 16); ss += __shfl_xor(ss, 32);
                if (fq == 0) atomicAdd(rss + row, ss);
                asm volatile("" ::: "memory");
            }
        asm volatile("s_waitcnt vmcnt(0)" ::: "memory");
        __syncthreads();
        if (threadIdx.x == 0) {
            __hip_atomic_fetch_add(pcnt, 1u, __ATOMIC_RELAXED, __HIP_MEMORY_SCOPE_AGENT);
            unsigned sp = 0;
            while (__hip_atomic_load(pcnt, __ATOMIC_RELAXED, __HIP_MEMORY_SCOPE_AGENT) < 4u && ++sp < (1u << 22)) __builtin_amdgcn_s_sleep(2);
        }
        __syncthreads();
#pragma unroll
        for (int ai = 0; ai < 2; ++ai)
#pragma unroll
            for (int m = 0; m < 4; ++m) {
                const int row = u.pm * BM + ai * HALF + wr * 64 + m * 16 + fr;
                const float rs = __builtin_amdgcn_rsqf(__hip_atomic_load(rss + row, __ATOMIC_RELAXED, __HIP_MEMORY_SCOPE_AGENT) * (1.0f / 1024.0f) + NORM_EPS);
#pragma unroll
                for (int bj = 0; bj < 2; ++bj) {
                    const int col = u.pn * BM + bj * HALF + colw; const size_t off = (size_t)row * 1024 + col;
                    const f32x4 g0 = *(const f32x4*)(a.final_g + col), g1 = *(const f32x4*)(a.final_g + col + 4);
                    const f32x4 h0 = acc[ai][bj][m][0] + *(const f32x4*)(a.out + off), h1 = acc[ai][bj][m][1] + *(const f32x4*)(a.out + off + 4);
                    *(f32x4*)(a.out + off) = h0 * rs * g0; *(f32x4*)(a.out + off + 4) = h1 * rs * g1;
                }
                asm volatile("" ::: "memory");
            }
    } else if (mode == E_OUT_EVEN) {
        const float* base = (mode == E_OUT_EVEN) ? a.x : a.out;
        float* rss = (float*)(ws + (mode == E_OUT_EVEN ? WS_RSS1 : WS_RSS2));
        h16* H1 = (h16*)(ws + WS_XN);
#pragma unroll
        for (int ai = 0; ai < 2; ++ai)
#pragma unroll
            for (int m = 0; m < 4; ++m) {
                const int row = u.pm * BM + ai * HALF + wr * 64 + m * 16 + fr;
                float ss = 0.f;
#pragma unroll
                for (int bj = 0; bj < 2; ++bj) {
                    const int col = u.pn * BM + bj * HALF + colw;
                    const size_t off = (size_t)row * 1024 + col;
                    const f32x4 x0 = *(const f32x4*)(base + off), x1 = *(const f32x4*)(base + off + 4);
                    const f32x4 h0 = x0 + acc[ai][bj][m][0], h1 = x1 + acc[ai][bj][m][1];
                    *(f32x4*)(a.out + off) = h0; *(f32x4*)(a.out + off + 4) = h1;
                    if (mode == E_OUT_EVEN) *(f16x8*)(H1 + off) = cvt8(h0, h1);
#pragma unroll
                    for (int j = 0; j < 4; ++j) ss += h0[j] * h0[j] + h1[j] * h1[j];
                }
                ss += __shfl_xor(ss, 16); ss += __shfl_xor(ss, 32);
                if (fq == 0) atomicAdd(rss + row, ss);
            }
    } else if (mode == E_ODD_IN) {
        const int pn = u.pn;
        const float* rss = (const float*)(ws + WS_RSS1);
        const float* ROPE = (const float*)(ws + WS_ROPE);
#pragma unroll
        for (int ai = 0; ai < 2; ++ai)
#pragma unroll
            for (int m = 0; m < 4; ++m) {
                const int row = u.pm * BM + ai * HALF + wr * 64 + m * 16 + fr;
                const float rs = __builtin_amdgcn_rsqf(rss[row] * (1.0f / 1024.0f) + NORM_EPS);
                const int pos = row & (SEQ - 1);
#pragma unroll
                for (int bj = 0; bj < 2; ++bj) {
                    const int col = pn * BM + bj * HALF + colw;
                    f32x4 v0 = acc[ai][bj][m][0] * rs, v1 = acc[ai][bj][m][1] * rs;
                    const bool ropeT = (pn < 4) || pn == 8 || pn == 10 || pn == 11 || (pn == 12 && col < 3072 + 64);
                    if (ropeT && (col & 63) < 16) {
                        const int i0 = (col & 63) >> 1;
                        const f32x4 cs0 = *(const f32x4*)(ROPE + pos * 16 + i0 * 2), cs1 = *(const f32x4*)(ROPE + pos * 16 + i0 * 2 + 4);
                        f32x4 r0, r1;
                        r0[0] = v0[0] * cs0[0] - v0[1] * cs0[1]; r0[1] = v0[0] * cs0[1] + v0[1] * cs0[0];
                        r0[2] = v0[2] * cs0[2] - v0[3] * cs0[3]; r0[3] = v0[2] * cs0[3] + v0[3] * cs0[2];
                        r1[0] = v1[0] * cs1[0] - v1[1] * cs1[1]; r1[1] = v1[0] * cs1[1] + v1[1] * cs1[0];
                        r1[2] = v1[2] * cs1[2] - v1[3] * cs1[3]; r1[3] = v1[2] * cs1[3] + v1[3] * cs1[2];
                        v0 = r0; v1 = r1;
                    }
                    if (pn < 4) *(f16x8*)((h16*)(ws + WS_Q) + (size_t)row * 1024 + col) = cvt8(v0 * 0.18033688011112042f, v1 * 0.18033688011112042f);
                    else if (pn < 8) {
#pragma unroll
                        for (int j = 0; j < 4; ++j) { v0[j] = siluf_(v0[j]); v1[j] = siluf_(v1[j]); }
                        *(f16x8*)((h16*)(ws + WS_ZS) + (size_t)row * 1024 + (col - 1024)) = cvt8(v0, v1);
                    } else if (pn == 8) *(f16x8*)((h16*)(ws + WS_KB) + (size_t)row * 256 + (col - 2048)) = cvt8(v0, v1);
                    else if (pn == 9) *(f16x8*)((h16*)(ws + WS_VB) + (size_t)row * 256 + (col - 2304)) = cvt8(v0, v1);
                    else if (pn < 12) *(f16x8*)((h16*)(ws + WS_QI) + (size_t)row * 512 + (col - 2560)) = cvt8(v0, v1);
                    else {
                        const int cl = col - 3072;
                        if (cl < 64) *(f16x8*)((h16*)(ws + WS_KI) + (size_t)row * 64 + cl) = cvt8(v0, v1);
                        else if (cl == 64) { float* w = (float*)(ws + WS_WI) + (size_t)row * 8; *(f32x4*)w = v0 * 0.04419417382415922f; *(f32x4*)(w + 4) = v1 * 0.04419417382415922f; }
                    }
                }
            }
    }
}

__device__ __forceinline__ void gemm_phase(LAS unsigned char* lds, const GemmP g, const int mode, const Args& a, const int G, const int c) {
    int tid = threadIdx.x; asm volatile("" : "+v"(tid));
    const int wid = __builtin_amdgcn_readfirstlane(tid >> 6), lane = tid & 63, wr = wid >> 2, wc = wid & 3, fr = lane & 15, fq = lane >> 4;
    const int nt = g.K / BK;
    unsigned voffA[2], voffB[2];
#pragma unroll
    for (int i = 0; i < 2; ++i) { int R, C; stage_rc(tid * 16 + i * 8192, R, C); const int Rb = (R & ~31) + perm32(R & 31);
        voffA[i] = (unsigned)(R * g.lda + C) * 2u; voffB[i] = (unsigned)(Rb * g.ldb + C) * 2u; }
    const size_t kstep = (size_t)(BK * 2);
    const size_t hstepA = (size_t)HALF * g.lda * 2, hstepB = (size_t)HALF * g.ldb * 2;
    const unsigned ldsw = (unsigned)wid * 1024u;
    const int aoff = lds_byte(wr * 64 + fr, fq * 8), boff = lds_byte(wc * 32 + fr, fq * 8);
#define PG8_SA(b, h) (((b) * 2 + (h)) * HTB)
#define PG8_SB(b, h) ((4 + (b) * 2 + (h)) * HTB)
#define PG8_STAGE(bufoff, gbase, voff) do { _Pragma("unroll") for (int _i = 0; _i < 2; ++_i) \
        __builtin_amdgcn_global_load_lds((const unsigned*)((const char*)(gbase) + (voff)[_i]), (LAS unsigned*)(lds + (bufoff) + ldsw + _i * 8192), 16, 0, 0); } while (0)
#define PG8_LDA(dst, b, h) do { _Pragma("unroll") for (int m = 0; m < 4; ++m) _Pragma("unroll") for (int k = 0; k < 2; ++k) dst[m][k] = *(const LAS f16x8*)(lds + PG8_SA(b, h) + aoff + m * 2048 + k * 1024); } while (0)
#define PG8_LDB(dst, b, h) do { _Pragma("unroll") for (int n = 0; n < 2; ++n) _Pragma("unroll") for (int k = 0; k < 2; ++k) dst[n][k] = *(const LAS f16x8*)(lds + PG8_SB(b, h) + boff + n * 2048 + k * 1024); } while (0)
#define PG8_MMA(ai, bj, At, Bt) do { __builtin_amdgcn_s_setprio(1); _Pragma("unroll") for (int m = 0; m < 4; ++m) _Pragma("unroll") for (int n = 0; n < 2; ++n) _Pragma("unroll") for (int k = 0; k < 2; ++k) \
        acc[ai][bj][m][n] = __builtin_amdgcn_mfma_f32_16x16x32_f16(Bt[n][k], At[m][k], acc[ai][bj][m][n], 0, 0, 0); __builtin_amdgcn_s_setprio(0); } while (0)
#define PG8_WAIT_V(n) asm volatile("s_waitcnt vmcnt(" #n ")" ::: "memory")
#define PG8_WAIT_L(n) asm volatile("s_waitcnt lgkmcnt(" #n ")" ::: "memory")
#define PG8_BAR __builtin_amdgcn_s_barrier()
#define PG8_SCHED __builtin_amdgcn_sched_barrier(0)
    Unit cur, nxt; int ui = 0;
    if (!unit_next(g, 0, G, c, cur)) return;
    f32x4 acc[2][2][4][2];
#pragma unroll
    for (int a_ = 0; a_ < 2; ++a_)
#pragma unroll
        for (int b = 0; b < 2; ++b)
#pragma unroll
            for (int m = 0; m < 4; ++m)
#pragma unroll
                for (int n = 0; n < 2; ++n) acc[a_][b][m][n] = (f32x4){0.f, 0.f, 0.f, 0.f};
    f16x8 At[4][2], B0[2][2], B1[2][2];
    const char* cA = g.A + (size_t)cur.grp * g.gsA + (size_t)cur.pm * 2 * hstepA; const char* cB = g.Bt + (size_t)cur.grp * g.gsB + (size_t)cur.pn * 2 * hstepB;
    PG8_STAGE(PG8_SB(0, 0), cB, voffB); PG8_STAGE(PG8_SB(0, 1), cB + hstepB, voffB); PG8_STAGE(PG8_SA(0, 0), cA, voffA); PG8_STAGE(PG8_SA(0, 1), cA + hstepA, voffA);
    if (wr == 1) PG8_BAR;
    PG8_WAIT_V(2); PG8_BAR;
    PG8_STAGE(PG8_SB(1, 0), cB + kstep, voffB); PG8_STAGE(PG8_SA(1, 0), cA + kstep, voffA); PG8_STAGE(PG8_SB(1, 1), cB + hstepB + kstep, voffB);
    PG8_WAIT_V(6); PG8_BAR;
    for (;;) {
        const bool has_next = unit_next(g, ui + 1, G, c, nxt);
        const char* nA = has_next ? g.A + (size_t)nxt.grp * g.gsA + (size_t)nxt.pm * 2 * hstepA : cA; const char* nB = has_next ? g.Bt + (size_t)nxt.grp * g.gsB + (size_t)nxt.pn * 2 * hstepB : cB;
        for (int t = 0; t < nt; t += 2) {
            const bool last = (t == nt - 2);
            const char* a1 = cA + (size_t)(t + 1) * kstep;
            const char* a2 = last ? nA : cA + (size_t)(t + 2) * kstep; const char* b2 = last ? nB : cB + (size_t)(t + 2) * kstep;
            const char* a3 = a2 + kstep; const char* b3 = b2 + kstep;
            PG8_LDB(B0, 0, 0); PG8_LDB(B1, 0, 1); PG8_SCHED; PG8_LDA(At, 0, 0); PG8_STAGE(PG8_SA(1, 1), a1 + hstepA, voffA);
            PG8_WAIT_V(8); PG8_WAIT_L(0); PG8_BAR; PG8_MMA(0, 0, At, B0); PG8_MMA(0, 1, At, B1); PG8_BAR; PG8_SCHED;
            PG8_LDA(At, 0, 1); PG8_STAGE(PG8_SB(0, 0), b2, voffB); PG8_STAGE(PG8_SB(0, 1), b2 + hstepB, voffB); PG8_STAGE(PG8_SA(0, 0), a2, voffA);
            PG8_WAIT_V(8); PG8_WAIT_L(0); PG8_BAR; PG8_MMA(1, 0, At, B0); PG8_MMA(1, 1, At, B1); PG8_BAR; PG8_SCHED;
            PG8_LDB(B0, 1, 0); PG8_LDB(B1, 1, 1); PG8_SCHED; PG8_LDA(At, 1, 0); PG8_STAGE(PG8_SA(0, 1), a2 + hstepA, voffA);
            PG8_WAIT_V(8); PG8_WAIT_L(0); PG8_BAR; PG8_MMA(0, 0, At, B0); PG8_MMA(0, 1, At, B1); PG8_BAR; PG8_SCHED;
            PG8_LDA(At, 1, 1); PG8_STAGE(PG8_SB(1, 0), b3, voffB); PG8_STAGE(PG8_SB(1, 1), b3 + hstepB, voffB); PG8_STAGE(PG8_SA(1, 0), a3, voffA);
            PG8_WAIT_V(8); PG8_WAIT_L(0); PG8_BAR; PG8_MMA(1, 0, At, B0); PG8_MMA(1, 1, At, B1); PG8_BAR; PG8_SCHED;
        }
        if (wr == 0) PG8_BAR;
        epilogue(mode, a, acc, cur, wr, wc, fr, fq);
        if (!has_next) break;
#pragma unroll
        for (int a_ = 0; a_ < 2; ++a_)
#pragma unroll
            for (int b = 0; b < 2; ++b)
#pragma unroll
                for (int m = 0; m < 4; ++m)
#pragma unroll
                    for (int n = 0; n < 2; ++n) acc[a_][b][m][n] = (f32x4){0.f, 0.f, 0.f, 0.f};
        cur = nxt; cA = nA; cB = nB; ++ui;
        if (wr == 1) PG8_BAR;
    }
    PG8_WAIT_V(0);
    PG8_BAR;
#undef PG8_SA
#undef PG8_SB
#undef PG8_STAGE
#undef PG8_LDA
#undef PG8_LDB
#undef PG8_MMA
#undef PG8_WAIT_V
#undef PG8_WAIT_L
#undef PG8_BAR
#undef PG8_SCHED
}

__device__ __forceinline__ int src_col_e_in(int n) { if (n < 1024 || n >= 2048) return n; const int j = (n - 1024) >> 8, w = (n - 1024) & 255; return w < 128 ? 1024 + 128 * j + w : 1536 + 128 * j + (w - 128); }
__device__ __forceinline__ int rot_dim(int p) { return p < 16 ? ((p & 1) ? 8 + (p >> 1) : (p >> 1)) : p; }
__device__ __forceinline__ int src_col_o_in(int n) {
    if (n < 1024) return (n & ~63) + rot_dim(n & 63);
    if (n < 2048) return n;
    if (n < 2304) return (n & ~63) + rot_dim(n & 63);
    if (n < 2560) return n;
    if (n < 3136) return (n & ~63) + rot_dim(n & 63);
    if (n < NO_IN) return n;
    return -1;
}
template <int MAP> __device__ __forceinline__ void conv_w(const float* src, int K, int Nsrc, h16* dst, int Nout, const float* kscale, LAS float* scr, int item, int lane) {
    const int nblk = Nout / 32, kb = item / nblk, nb = item % nblk, k0 = 64 * kb, n0 = 32 * nb;
    const int m0 = (MAP == 1) ? src_col_e_in(n0) : (MAP == 2) ? src_col_o_in(n0) : n0;
    const int sb = m0 & ~31, sc = sb + (lane & 31);
#pragma unroll 8
    for (int i = 0; i < 32; ++i) { const int kk = 2 * i + (lane >> 5); scr[kk * 33 + (lane & 31)] = (sc >= 0 && sc < Nsrc) ? src[(size_t)(k0 + kk) * Nsrc + sc] : 0.f; }
    asm volatile("s_waitcnt lgkmcnt(0)" ::: "memory");
    const int cch = lane & 7;
    f32x4 ks0 = (f32x4){1.f, 1.f, 1.f, 1.f}, ks1 = ks0;
    if (kscale) { ks0 = *(const f32x4*)(kscale + k0 + 8 * cch); ks1 = *(const f32x4*)(kscale + k0 + 8 * cch + 4); }
#pragma unroll
    for (int j = 0; j < 4; ++j) {
        const int n = n0 + (lane >> 3) + 8 * j;
        const int m = (MAP == 1) ? src_col_e_in(n) : (MAP == 2) ? src_col_o_in(n) : n;
        f16x8 o = (f16x8){};
        if (m >= 0) { const LAS float* p = scr + (8 * cch) * 33 + (m - sb);
            o[0] = (h16)(p[0] * ks0[0]); o[1] = (h16)(p[33] * ks0[1]); o[2] = (h16)(p[66] * ks0[2]); o[3] = (h16)(p[99] * ks0[3]);
            o[4] = (h16)(p[132] * ks1[0]); o[5] = (h16)(p[165] * ks1[1]); o[6] = (h16)(p[198] * ks1[2]); o[7] = (h16)(p[231] * ks1[3]); }
        *(f16x8*)(dst + (size_t)n * K + k0 + 8 * cch) = o;
    }
    asm volatile("s_waitcnt lgkmcnt(0)" ::: "memory");
}

constexpr int S5T_PWR = 0, S5T_PWI = 1088, S5T_BBR = 2176, S5T_BBI = 3200, S5T_CR = 4224, S5T_CI = 5248, S5T_KT = 6272, S5T_STRIDE = 10368;
__device__ __forceinline__ void s5_tables(const Args& a, LAS unsigned char* lds, int g, int part) {
    LAS float* F = (LAS float*)lds;
    LAS float* PWr = F, *PWi = F + 1088, *KKr = F + 2176, *KKi = F + 2240, *BBr = F + 2304, *BBi = F + 3328, *Cr = F + 4352, *Ci = F + 5376;
    float* T = (float*)(a.ws + WS_S5T) + (size_t)g * S5T_STRIDE;
    int tid = threadIdx.x; asm volatile("" : "+v"(tid));
    const float dt = expf(a.e_log_step[g]);
    for (int e = tid; e < 1088; e += NTHREADS) {
        const int n = e / 17, j = e % 17;
        const float lr = fminf(a.e_lam_re[g * 64 + n], -1e-4f), li = a.e_lam_im[g * 64 + n];
        const float mag = expf((float)j * (lr * dt)); float s, c; sincosf((float)j * (li * dt), &s, &c);
        PWr[e] = mag * c; PWi[e] = mag * s;
    }
    if (tid < 64) {
        const int n = tid;
        const float lr = fminf(a.e_lam_re[g * 64 + n], -1e-4f), li = a.e_lam_im[g * 64 + n];
        float s, c, sh, ch; sincosf(li * dt, &s, &c); sincosf(0.5f * li * dt, &sh, &ch);
        const float em1 = expm1f(lr * dt);
        const float nr = em1 * c - 2.0f * sh * sh, ni = (em1 + 1.0f) * s, den = lr * lr + li * li;
        KKr[n] = (nr * lr + ni * li) / den; KKi[n] = (ni * lr - nr * li) / den;
        if (part == 0) { const float m16 = expf(16.0f * (lr * dt)); float s16, c16; sincosf(16.0f * (li * dt), &s16, &c16);
            float* abt = (float*)(a.ws + WS_ABT) + (size_t)(g * 64 + n) * 2; abt[0] = m16 * c16; abt[1] = m16 * s16; }
    }
    __syncthreads();
    for (int e = tid; e < 1024; e += NTHREADS) {
        { const int n = e >> 4, cc = e & 15; const float br = a.e_b_re[(size_t)(g * 64 + n) * 16 + cc], bi = a.e_b_im[(size_t)(g * 64 + n) * 16 + cc];
          BBr[e] = KKr[n] * br - KKi[n] * bi; BBi[e] = KKr[n] * bi + KKi[n] * br; }
        { const int cc = e >> 6, n = e & 63; Cr[e] = a.e_c_re[(size_t)(g * 16 + cc) * 64 + n]; Ci[e] = a.e_c_im[(size_t)(g * 16 + cc) * 64 + n]; }
    }
    __syncthreads();
    {
        const int e = part * 512 + tid, tau = e >> 8, cc = (e >> 4) & 15, cp = e & 15; float s = 0.f;
        for (int n = 0; n < 64; ++n) {
            const float cr = Cr[cc * 64 + n], ci = Ci[cc * 64 + n], pr = PWr[n * 17 + tau], pi = PWi[n * 17 + tau];
            const float tr = cr * pr - ci * pi, ti = cr * pi + ci * pr;
            s += tr * BBr[n * 16 + cp] - ti * BBi[n * 16 + cp];
        }
        T[S5T_KT + e] = s;
    }
    if (part == 0) { for (int e = tid; e < 6272; e += NTHREADS) T[e] = (e < 2176) ? F[e] : F[e + 128]; }
    __syncthreads();
}
__device__ __forceinline__ void s5_fill(const Args& a, int G, int bid) {
    int tid = threadIdx.x; asm volatile("" : "+v"(tid));
    const float* TB = (const float*)(a.ws + WS_S5T);
    for (int e = bid * NTHREADS + tid; e < 32 * 256 * 48; e += G * NTHREADS) {
        const int g = e / (256 * 48), r = e % (256 * 48), row = r / 48, cg = r % 48, t = row >> 4, cc = row & 15; const float* T = TB + (size_t)g * S5T_STRIDE; f16x8 o;
#pragma unroll
        for (int j = 0; j < 8; ++j) {
            const int col = cg * 8 + j; float v;
            if (col < 256) { const int tp = col >> 4, cp = col & 15; v = (t >= tp) ? T[S5T_KT + (t - tp) * 256 + cc * 16 + cp] : 0.f; }
            else { const int q = col - 256, n = q >> 1, ri = q & 1; const float cr = T[S5T_CR + cc * 64 + n], ci = T[S5T_CI + cc * 64 + n], pr = T[S5T_PWR + n * 17 + t + 1], pi = T[S5T_PWI + n * 17 + t + 1];
                   v = ri == 0 ? (cr * pr - ci * pi) : -(cr * pi + ci * pr); }
            o[j] = (h16)v;
        }
        *(f16x8*)((h16*)(a.ws + WS_MY) + (size_t)g * (256 * 384) + (size_t)row * 384 + cg * 8) = o;
    }
    for (int e = bid * NTHREADS + tid; e < 32 * 256 * 32; e += G * NTHREADS) {
        const int g = e >> 13, r = e & 8191, row = r >> 5, cg = r & 31; const float* T = TB + (size_t)g * S5T_STRIDE; f16x8 o;
#pragma unroll
        for (int j = 0; j < 8; ++j) {
            float v = 0.f;
            if (row < 128) { const int n = row >> 1, ri = row & 1, col = cg * 8 + j, tp = col >> 4, cp = col & 15;
                const float pr = T[S5T_PWR + n * 17 + 15 - tp], pi = T[S5T_PWI + n * 17 + 15 - tp], br = T[S5T_BBR + n * 16 + cp], bi = T[S5T_BBI + n * 16 + cp];
                v = ri == 0 ? (pr * br - pi * bi) : (pr * bi + pi * br); }
            o[j] = (h16)v;
        }
        *(f16x8*)((h16*)(a.ws + WS_MS) + (size_t)g * (256 * 256) + (size_t)row * 256 + cg * 8) = o;
    }
}

__device__ __forceinline__ void p0_prologue(const Args& a, LAS unsigned char* lds, int G, int bid) {
    int tid = threadIdx.x; asm volatile("" : "+v"(tid));
    const int lane = tid & 63, wave = tid >> 6;
    unsigned char* ws = a.ws;
    s5_tables(a, lds, (bid >> 3) & 31, bid & 7);
    const int bid2 = bid, G2 = G;
    const long gtid = (long)bid2 * NTHREADS + tid, gstr = (long)G2 * NTHREADS;
    {
        LAS float* scr = (LAS float*)(lds + wave * 8448);
        constexpr int I0 = 16 * (NE_IN / 32), I1 = 8 * 16, I2 = 16 * 32, I3 = 16 * (NO_PAD / 32), I4 = 16 * 32;
        for (int it = bid * 8 + wave; it < I0 + I1 + I2 + I3 + I4; it += G * 8) {
            int r = it;
            if (r < I0) { conv_w<1>(a.e_w_in, 1024, NE_IN, (h16*)(ws + WS_WE_IN), NE_IN, nullptr, scr, r, lane); continue; } r -= I0;
            if (r < I1) { conv_w<0>(a.e_w_glu, 512, 512, (h16*)(ws + WS_WGLU), 512, nullptr, scr, r, lane); continue; } r -= I1;
            if (r < I2) { conv_w<0>(a.e_w_out, 1024, 1024, (h16*)(ws + WS_WE_OUT), 1024, nullptr, scr, r, lane); continue; } r -= I2;
            if (r < I3) { conv_w<2>(a.o_w_in, 1024, NO_IN, (h16*)(ws + WS_WO_IN), NO_PAD, a.norm_g + 1024, scr, r, lane); continue; } r -= I3;
            conv_w<0>(a.o_w_out, 1024, 1024, (h16*)(ws + WS_WO_OUT), 1024, nullptr, scr, r, lane);
        }
    }
    for (long idx = gtid; idx < 4096 * 8; idx += gstr) {
        const int pos = (int)(idx >> 3), i = (int)(idx & 7);
        const float inv = i == 0 ? 0x1.0000000000000p+0f : i == 1 ? 0x1.8d275e0000000p-3f : i == 2 ? 0x1.3411900000000p-5f : i == 3 ? 0x1.ddee9c0000000p-8f
                        : i == 4 ? 0x1.72ba440000000p-10f : i == 5 ? 0x1.1f91f00000000p-12f : i == 6 ? 0x1.be218a0000000p-15f : 0x1.5a0f500000000p-17f;
        const float ang = (float)pos * inv; float s, c; sincosf(ang, &s, &c);
        float* r = (float*)(ws + WS_ROPE) + idx * 2; r[0] = c; r[1] = s;
    }
    h16* XN = (h16*)(ws + WS_XN);
    for (int row = bid2 * 8 + wave; row < MTOK; row += G2 * 8) {
        const f32x4* xr = (const f32x4*)(a.x + (size_t)row * 1024) + lane;
        f32x4 v[4]; float s = 0.f;
#pragma unroll
        for (int j = 0; j < 4; ++j) { v[j] = xr[64 * j]; s += (v[j][0] * v[j][0] + v[j][1] * v[j][1]) + (v[j][2] * v[j][2] + v[j][3] * v[j][3]); }
        const float rs = __builtin_amdgcn_rsqf(wave_sum(s) * (1.0f / 1024.0f) + NORM_EPS);
#pragma unroll
        for (int j = 0; j < 4; ++j) { const f32x4 gg = *((const f32x4*)a.norm_g + lane + 64 * j); f16x4 o;
            o[0] = (h16)(v[j][0] * rs * gg[0]); o[1] = (h16)(v[j][1] * rs * gg[1]); o[2] = (h16)(v[j][2] * rs * gg[2]); o[3] = (h16)(v[j][3] * rs * gg[3]);
            *((f16x4*)(XN + (size_t)row * 1024) + lane + 64 * j) = o; }
    }
}

__device__ __forceinline__ void conv_phase(const Args& a, LAS unsigned char* lds, int G, int bid) {
    LAS h16* Hs = (LAS h16*)lds;
    LAS float* Cs = (LAS float*)(lds + 65536);
    const h16* HB = (const h16*)(a.ws + WS_HB); const h16* ZB = (const h16*)(a.ws + WS_ZB); h16* YC = (h16*)(a.ws + WS_YCAT);
    int tid = threadIdx.x; asm volatile("" : "+v"(tid));
    const int lane = tid & 63, wave = tid >> 6;
    const int cp = tid & 255, th = tid >> 8;
    for (int unit = bid; unit < 1024; unit += G) {
        const int b = unit >> 7, t0 = (unit & 127) * 32;
        for (int e = tid; e < 62 * 64; e += NTHREADS) {
            const int r = e >> 6, ch = e & 63, tok = t0 - 30 + r; f16x8 v = (f16x8){0, 0, 0, 0, 0, 0, 0, 0};
            if (tok >= 0) v = *(const f16x8*)(HB + ((size_t)(b * SEQ + tok)) * 512 + ch * 8);
            *(LAS f16x8*)(Hs + r * 512 + ch * 8) = v;
        }
        __syncthreads();
        {
            float w0[31], w1[31];
#pragma unroll
            for (int j = 0; j < 31; ++j) { const f32x2 w = *(const f32x2*)(a.e_conv_w + j * 512 + 2 * cp); w0[j] = w[0]; w1[j] = w[1]; }
            const f32x2 bias = *(const f32x2*)(a.e_conv_b + 2 * cp);
            float a0[16], a1[16];
#pragma unroll
            for (int t = 0; t < 16; ++t) { a0[t] = bias[0]; a1[t] = bias[1]; }
#pragma unroll
            for (int r = 0; r < 46; ++r) {
                const f16x2 hv = *(const LAS f16x2*)(Hs + (16 * th + r) * 512 + 2 * cp);
                const float h0 = (float)hv[0], h1 = (float)hv[1];
#pragma unroll
                for (int t = 0; t < 16; ++t) { const int j = r - t; if (j >= 0 && j <= 30) { a0[t] += w0[j] * h0; a1[t] += w1[j] * h1; } }
            }
#pragma unroll
            for (int t = 0; t < 16; ++t) *(LAS f32x2*)(Cs + (16 * th + t) * 512 + 2 * cp) = (f32x2){a0[t], a1[t]};
        }
        __syncthreads();
#pragma unroll
        for (int tt = 0; tt < 4; ++tt) {
            const int t = wave * 4 + tt; const size_t tok = (size_t)b * SEQ + t0 + t;
            const f32x4 c0 = *(const LAS f32x4*)(Cs + t * 512 + lane * 8), c1 = *(const LAS f32x4*)(Cs + t * 512 + lane * 8 + 4);
            const float mean = wave_sum((c0[0] + c0[1]) + (c0[2] + c0[3]) + (c1[0] + c1[1]) + (c1[2] + c1[3])) * (1.0f / 512.0f);
            const f32x4 d0 = c0 - mean, d1 = c1 - mean;
            const float var = wave_sum((d0[0] * d0[0] + d0[1] * d0[1]) + (d0[2] * d0[2] + d0[3] * d0[3]) + (d1[0] * d1[0] + d1[1] * d1[1]) + (d1[2] * d1[2] + d1[3] * d1[3])) * (1.0f / 512.0f);
            const float rstd = __builtin_amdgcn_rsqf(var + NORM_EPS);
            const f32x4 g0 = *(const f32x4*)(a.e_ln_g + lane * 8), g1 = *(const f32x4*)(a.e_ln_g + lane * 8 + 4), b0 = *(const f32x4*)(a.e_ln_b + lane * 8), b1 = *(const f32x4*)(a.e_ln_b + lane * 8 + 4);
            const f16x8 zb = *(const f16x8*)(ZB + tok * 512 + lane * 8);
            f32x4 o0, o1;
#pragma unroll
            for (int j = 0; j < 4; ++j) { o0[j] = siluf_(d0[j] * rstd * g0[j] + b0[j]) * (float)zb[j]; o1[j] = siluf_(d1[j] * rstd * g1[j] + b1[j]) * (float)zb[4 + j]; }
            *(f16x8*)(YC + tok * 1024 + 512 + lane * 8) = cvt8(o0, o1);
        }
        __syncthreads();
    }
}

__device__ __forceinline__ void scan_phase(const Args& a, LAS unsigned char* lds, int G, int bid) {
    int tid = threadIdx.x; asm volatile("" : "+v"(tid));
    const int lane = tid & 63, wave = tid >> 6;
    LAS f32x2* E = (LAS f32x2*)lds;
    for (int task = bid; task < 256; task += G) {
        const int g = task >> 3, b = task & 7, n = lane;
        const f32x2 abt = *(const f32x2*)((const float*)(a.ws + WS_ABT) + (size_t)(g * 64 + n) * 2);
        const float* se = (const float*)(a.ws + WS_SEND) + ((size_t)g * 2048 + b * 256 + wave * 32) * 128 + 2 * n;
        h16* up = (h16*)(a.ws + WS_UA) + ((size_t)g * 2048 + b * 256 + wave * 32) * 384 + 256 + 2 * n;
        f32x2 e[32];
#pragma unroll
        for (int k = 0; k < 32; ++k) e[k] = *(const f32x2*)(se + (size_t)k * 128);
        float sr = 0.f, si = 0.f;
#pragma unroll
        for (int k = 0; k < 32; ++k) {
            const float er = e[k][0], ei = e[k][1];
            e[k][0] = sr; e[k][1] = si;
            const float nr = abt[0] * sr - abt[1] * si + er, ni = abt[0] * si + abt[1] * sr + ei;
            sr = nr; si = ni;
        }
        E[wave * 64 + n] = (f32x2){sr, si};
        float pr = abt[0], pi = abt[1];
#pragma unroll
        for (int q = 0; q < 5; ++q) { const float tr = pr * pr - pi * pi, ti = 2.f * pr * pi; pr = tr; pi = ti; }
        __syncthreads();
        float cr = 0.f, ci = 0.f;
        for (int w = 0; w < wave; ++w) { const f32x2 ew = E[w * 64 + n]; const float tr = pr * cr - pi * ci + ew[0], ti = pr * ci + pi * cr + ew[1]; cr = tr; ci = ti; }
        float qr_ = 1.f, qi_ = 0.f;
#pragma unroll
        for (int k = 0; k < 32; ++k) {
            const float orr = e[k][0] + (qr_ * cr - qi_ * ci), oi = e[k][1] + (qr_ * ci + qi_ * cr);
            f16x2 o; o[0] = (h16)orr; o[1] = (h16)oi; *(f16x2*)(up + (size_t)k * 384) = o;
            const float tr = qr_ * abt[0] - qi_ * abt[1], ti = qr_ * abt[1] + qi_ * abt[0]; qr_ = tr; qi_ = ti;
        }
        __syncthreads();
    }
}

constexpr int SEL_CAP = 128;
__device__ __forceinline__ float relu_(float x) { const int i = __float_as_int(x); return __int_as_float(i > 0 ? i : 0); }
__device__ __forceinline__ unsigned sortkey(float s) { const unsigned u = __float_as_uint(s); return (u & 0x80000000u) ? ~u : (u | 0x80000000u); }

__device__ __forceinline__ void lds_add_u32(LAS unsigned* p, unsigned v) { asm volatile("ds_add_u32 %0, %1" :: "v"((unsigned)(size_t)p), "v"(v) : "memory"); }
__device__ __forceinline__ void lds_store_u16(LAS unsigned short* p, unsigned v) { asm volatile("ds_write_b16 %0, %1" :: "v"((unsigned)(size_t)p), "v"(v) : "memory"); }
__device__ __forceinline__ void lds_store_u64(LAS unsigned long long* p, unsigned long long v) { asm volatile("ds_write_b64 %0, %1" :: "v"((unsigned)(size_t)p), "v"(v) : "memory"); }
__device__ __forceinline__ int lds_add_rtn(LAS int* p, int v) { int r; asm volatile("ds_add_rtn_u32 %0, %1, %2\n\ts_waitcnt lgkmcnt(0)" : "=v"(r) : "v"((unsigned)(size_t)p), "v"(v) : "memory"); return r; }
constexpr int IDX_NBIN = 896, IDX_HW = IDX_NBIN / 2, IDX_RING = 64 * IDX_HW * 4, IDX_SEL = IDX_RING + 5 * 8192;
template <int MODE> __device__ __forceinline__ void idx_pass(const Args& a, LAS unsigned char* lds, int b, int c, const f16x8 (&af)[4][2], const f32x4 (&wr_)[4], int wave, int lane) {
    const h16* KI = (const h16*)(a.ws + WS_KI) + (size_t)b * SEQ * 64;
    LAS unsigned* hist = (LAS unsigned*)lds;
    LAS unsigned short* mask16 = (LAS unsigned short*)lds;
    LAS unsigned long long* cand = (LAS unsigned long long*)(lds + 32768);
    LAS int* sel = (LAS int*)(lds + IDX_SEL);
    const int g4 = lane >> 4;
    const int qa = wave * 8 + (((g4 & 1) << 1) | (g4 >> 1)), qb = qa + 4;
    int bsa = 0, bsb = 0;
    if (MODE == 1) { bsa = sel[qa]; bsb = sel[qb]; }
    const h16* ksrc = KI + (size_t)lane * 64 + wave * 8;
    const unsigned dmaoff = (unsigned)wave * 1024u;
    const LAS unsigned char* fb = lds + IDX_RING + g4 * 1024 + (lane & 15) * 16;
#define IDX_DMA(J) __builtin_amdgcn_global_load_lds((const unsigned*)(ksrc + (size_t)(J) * 4096), (LAS unsigned*)(lds + IDX_RING + ((J) % 5) * 8192 + dmaoff), 16, 0, 0)
    IDX_DMA(0); IDX_DMA(1); IDX_DMA(2); IDX_DMA(3);
    asm volatile("s_waitcnt vmcnt(3) lgkmcnt(0)\n\ts_barrier" ::: "memory");
    for (int gi = 0; gi <= c; ++gi) {
        IDX_DMA(gi + 4);
        const LAS unsigned char* fs = fb + (gi % 5) * 8192;
#pragma unroll
        for (int hh = 0; hh < 2; ++hh) {
            f32x4 d[2][4];
#pragma unroll
            for (int t2 = 0; t2 < 2; ++t2) {
                const int tt = hh * 2 + t2;
                const f16x8 b0 = *(const LAS f16x8*)(fs + tt * 256), b1 = *(const LAS f16x8*)(fs + 4096 + tt * 256);
#pragma unroll
                for (int i = 0; i < 4; ++i) {
                    d[t2][i] = __builtin_amdgcn_mfma_f32_16x16x32_f16(af[i][0], b0, (f32x4){0.f, 0.f, 0.f, 0.f}, 0, 0, 0);
                    d[t2][i] = __builtin_amdgcn_mfma_f32_16x16x32_f16(af[i][1], b1, d[t2][i], 0, 0, 0);
                }
            }
#pragma unroll
            for (int t2 = 0; t2 < 2; ++t2) {
            const int tt = hh * 2 + t2;
            const int tile = gi * 4 + tt;
            float part[4];
#pragma unroll
            for (int i = 0; i < 4; ++i)
                part[i] = (__builtin_amdgcn_fmed3f(d[t2][i][0], 0.f, wr_[i][0]) + __builtin_amdgcn_fmed3f(d[t2][i][1], 0.f, wr_[i][1])) + (__builtin_amdgcn_fmed3f(d[t2][i][2], 0.f, wr_[i][2]) + __builtin_amdgcn_fmed3f(d[t2][i][3], 0.f, wr_[i][3]));
            const auto sa = __builtin_amdgcn_permlane16_swap(__float_as_uint(part[0]), __float_as_uint(part[1]), false, false);
            const auto sb = __builtin_amdgcn_permlane16_swap(__float_as_uint(part[2]), __float_as_uint(part[3]), false, false);
            const float sA = (__uint_as_float(sa[0]) + __uint_as_float(sa[1])) + 0.0f, sB = (__uint_as_float(sb[0]) + __uint_as_float(sb[1])) + 0.0f;
            const int key = tile * 16 + (lane & 15);
            const int binA = (int)fminf(fmaxf(fmaf(sA, 32.f, 448.f), 0.f), (float)(IDX_NBIN - 1)), binB = (int)fminf(fmaxf(fmaf(sB, 32.f, 448.f), 0.f), (float)(IDX_NBIN - 1));
            if (MODE == 0) {
                lds_add_u32(hist + qa * IDX_HW + (binA >> 1), (binA & 1) ? 65536u : 1u);
                lds_add_u32(hist + qb * IDX_HW + (binB >> 1), (binB & 1) ? 65536u : 1u);
            } else {
                const unsigned long long mA = __ballot(binA > bsa), mB = __ballot(binB > bsb);
                if (lane < 4) { const int q = wave * 8 + (((lane & 1) << 1) | (lane >> 1)); lds_store_u16(mask16 + q * 256 + tile, (unsigned)(mA >> (16 * lane)) & 0xffffu); }
                else if (lane < 8) { const int l = lane - 4; const int q = wave * 8 + 4 + (((l & 1) << 1) | (l >> 1)); lds_store_u16(mask16 + q * 256 + tile, (unsigned)(mB >> (16 * l)) & 0xffffu); }
                if (binA == bsa) { const int p = lds_add_rtn(sel + 128 + qa, 1); if (p < SEL_CAP) lds_store_u64(cand + qa * SEL_CAP + p, ((unsigned long long)sortkey(sA) << 32) | (unsigned)(4095 - key)); }
                if (binB == bsb) { const int p = lds_add_rtn(sel + 128 + qb, 1); if (p < SEL_CAP) lds_store_u64(cand + qb * SEL_CAP + p, ((unsigned long long)sortkey(sB) << 32) | (unsigned)(4095 - key)); }
            }
        }
        }
        asm volatile("s_waitcnt vmcnt(3) lgkmcnt(0)\n\ts_barrier" ::: "memory");
    }
    asm volatile("s_waitcnt vmcnt(0)" ::: "memory");
#undef IDX_DMA
}

__device__ __forceinline__ void idx_phase(const Args& a, LAS unsigned char* lds, int G, int bid) {
    int tid = threadIdx.x; asm volatile("" : "+v"(tid));
    const int lane = tid & 63, wave = tid >> 6;
    unsigned long long* MASK = (unsigned long long*)(a.ws + WS_MASK);
    for (int e = bid * NTHREADS + tid; e < NB * 4 * 4 * 64; e += G * NTHREADS) {
        const int q = e & 63, t = (e >> 6) & 3, c = (e >> 8) & 3, b = e >> 10;
        unsigned long long allsel = ~0ull; asm volatile("" : "+v"(allsel));
        if (t <= c) MASK[((size_t)(b * 64 + c) * 64 + t) * 64 + q] = allsel;
    }
    if (bid >= 240) return;
    const int b = bid / 30, j = bid % 30;
    LAS unsigned* hist = (LAS unsigned*)lds;
    LAS int* sel = (LAS int*)(lds + IDX_SEL);
    LAS unsigned* mask32 = (LAS unsigned*)lds;
    LAS unsigned long long* cand = (LAS unsigned long long*)(lds + 32768);
    for (int uu = 0; uu < 2; ++uu) {
        const int c = uu == 0 ? 63 - j : 4 + j;
        const size_t tok0 = (size_t)b * SEQ + c * 64;
        f16x8 af[4][2]; f32x4 wr_[4];
        {
            const h16* QI = (const h16*)(a.ws + WS_QI); const float* WI = (const float*)(a.ws + WS_WI);
#pragma unroll
            for (int i = 0; i < 4; ++i) {
                const size_t tq = tok0 + wave * 8 + 2 * i + ((lane & 15) >> 3);
                const h16* p = QI + tq * 512 + (lane & 7) * 64 + 8 * (lane >> 4);
                const float wrow = WI[tq * 8 + (lane & 7)];
                const f16x8 a0 = *(const f16x8*)p, a1 = *(const f16x8*)(p + 32);
#pragma unroll
                for (int j = 0; j < 8; ++j) { af[i][0][j] = (h16)((float)a0[j] * wrow); af[i][1][j] = (h16)((float)a1[j] * wrow); }
                const f32x4 wv = *(const f32x4*)(WI + (tok0 + wave * 8 + 2 * i + (lane >> 5)) * 8 + 4 * ((lane >> 4) & 1));
#pragma unroll
                for (int j = 0; j < 4; ++j) wr_[i][j] = wv[j] > 0.f ? INFINITY : -INFINITY;
            }
        }
        for (int e = tid; e < 64 * IDX_HW; e += NTHREADS) hist[e] = 0u;
        __syncthreads();
        idx_pass<0>(a, lds, b, c, af, wr_, wave, lane);
        __syncthreads();
        for (int ql = 0; ql < 8; ++ql) {
            const int q = wave * 8 + ql;
            unsigned cnt[14]; unsigned s = 0;
#pragma unroll
            for (int k = 0; k < 7; ++k) { const unsigned w = hist[q * IDX_HW + lane * 7 + k]; cnt[2 * k] = w & 0xffffu; cnt[2 * k + 1] = w >> 16; s += cnt[2 * k] + cnt[2 * k + 1]; }
            unsigned suf = s;
#pragma unroll
            for (int o = 1; o < 64; o <<= 1) { const unsigned t = __shfl_down(suf, o); if (lane + o < 64) suf += t; }
            const unsigned above = suf - s;
            if (suf >= 256u && above < 256u) {
                unsigned run = above; int bs = lane * 14; int need = 1;
#pragma unroll
                for (int k = 13; k >= 0; --k) { if (run < 256u && run + cnt[k] >= 256u) { bs = lane * 14 + k; need = 256 - (int)run; } run += cnt[k]; }
                sel[q] = bs; sel[64 + q] = need;
            }
        }
        __syncthreads();
        for (int e = tid; e < 8192; e += NTHREADS) mask32[e] = 0u;
        if (tid < 64) sel[128 + tid] = 0;
        __syncthreads();
        idx_pass<1>(a, lds, b, c, af, wr_, wave, lane);
        __syncthreads();
        for (int ql = 0; ql < 8; ++ql) {
            const int q = wave * 8 + ql; int n = sel[128 + q]; if (n > SEL_CAP) n = SEL_CAP; const int need = sel[64 + q];
            const unsigned long long c0 = lane < n ? cand[q * SEL_CAP + lane] : 0ull, c1 = (lane + 64) < n ? cand[q * SEL_CAP + lane + 64] : 0ull;
            int r0 = 0, r1 = 0;
            for (int i = 0; i < n; ++i) { const unsigned long long ci = cand[q * SEL_CAP + i]; r0 += (ci > c0) ? 1 : 0; r1 += (ci > c1) ? 1 : 0; }
            if (lane < n && r0 < need) { const int key = 4095 - (int)(c0 & 0xfffu); atomicOr((unsigned*)(mask32 + q * 128 + (key >> 5)), 1u << (key & 31)); }
            if (lane + 64 < n && r1 < need) { const int key = 4095 - (int)(c1 & 0xfffu); atomicOr((unsigned*)(mask32 + q * 128 + (key >> 5)), 1u << (key & 31)); }
        }
        __syncthreads();
        for (int e = tid; e < 64 * (c + 1); e += NTHREADS) {
            const int q = e & 63, t = e >> 6;
            MASK[((size_t)(b * 64 + c) * 64 + t) * 64 + q] = (unsigned long long)mask32[q * 128 + 2 * t] | ((unsigned long long)mask32[q * 128 + 2 * t + 1] << 32);
        }
        __syncthreads();
    }
}

__device__ __forceinline__ int crow(int r, int hi) { return (r & 3) + 8 * (r >> 2) + 4 * hi; }
#define ATT_THR 8.0f
constexpr int ATT_K = 0, ATT_V = 24576, ATT_M = 65536, ATT_Q = 69632, ATT_W = 135168;
__device__ __forceinline__ float bitsel_(int m, float a, unsigned cbits) { return __uint_as_float((__float_as_uint(a) & (unsigned)m) | (cbits & ~(unsigned)m)); }
__device__ __forceinline__ void att_tile(f32x16& s0, f32x16& s1, f32x16& n0, f32x16& n1, f16x8 (&pk)[4], f32x16& o0, f32x16& o1, float& lrun, float& mrun,
                                         const LAS unsigned char* qp, const LAS unsigned char* kn, const LAS unsigned char* vt, const unsigned long long mw, LAS float* wsf, const int hi, const int r32) {
    typedef short s16x8 __attribute__((ext_vector_type(8))); typedef short s16x4 __attribute__((ext_vector_type(4)));
    f16x8 kf[8];
#pragma unroll
    for (int d0 = 0; d0 < 2; ++d0) { kf[2 * d0] = *(const LAS f16x8*)(kn + d0 * 2048); kf[2 * d0 + 1] = *(const LAS f16x8*)(kn + d0 * 2048 + 512); }
    n0 = (f32x16){}; n1 = (f32x16){};
    f16x8 qr[4];
#pragma unroll
    for (int d0 = 0; d0 < 4; ++d0) qr[d0] = *(const LAS f16x8*)(qp + d0 * 1024);
    const int mlo = (int)(unsigned)(mw >> (4 * hi)), mhi = (int)(unsigned)(mw >> (32 + 4 * hi));
#define ATT_MF(j) do { if ((j) & 1) { n1 = __builtin_amdgcn_mfma_f32_32x32x16_f16(kf[j], qr[(j) >> 1], n1, 0, 0, 0); } \
                       else { n0 = __builtin_amdgcn_mfma_f32_32x32x16_f16(kf[j], qr[(j) >> 1], n0, 0, 0, 0); } } while (0)
#define ATT_MSK0(r) s0[r] = bitsel_(__builtin_amdgcn_sbfe(mlo, ((r) & 3) + 8 * ((r) >> 2), 1), s0[r], 0xff800000u)
#define ATT_MSK1(r) s1[r] = bitsel_(__builtin_amdgcn_sbfe(mhi, ((r) & 3) + 8 * ((r) >> 2), 1), s1[r], 0xff800000u)
    float mx;
    asm volatile("" : "+v"(kf[0]));
    ATT_MF(0);
    ATT_MSK0(0); ATT_MSK0(1); ATT_MSK0(2); ATT_MSK0(3); ATT_MSK0(4); ATT_MSK0(5); ATT_MSK0(6); ATT_MSK0(7);
    mx = fmaxf(fmaxf(s0[0], s0[1]), s0[2]); mx = fmaxf(fmaxf(mx, s0[3]), s0[4]); mx = fmaxf(fmaxf(mx, s0[5]), s0[6]); mx = fmaxf(mx, s0[7]);
    asm volatile("" : "+v"(kf[1]), "+v"(mx));
    ATT_MF(1);
    ATT_MSK0(8); ATT_MSK0(9); ATT_MSK0(10); ATT_MSK0(11); ATT_MSK0(12); ATT_MSK0(13); ATT_MSK0(14); ATT_MSK0(15);
    mx = fmaxf(fmaxf(mx, s0[8]), s0[9]); mx = fmaxf(fmaxf(mx, s0[10]), s0[11]); mx = fmaxf(fmaxf(mx, s0[12]), s0[13]); mx = fmaxf(fmaxf(mx, s0[14]), s0[15]);
    asm volatile("" : "+v"(kf[2]), "+v"(mx));
    ATT_MF(2);
    ATT_MSK1(0); ATT_MSK1(1); ATT_MSK1(2); ATT_MSK1(3); ATT_MSK1(4); ATT_MSK1(5); ATT_MSK1(6); ATT_MSK1(7);
    mx = fmaxf(fmaxf(mx, s1[0]), s1[1]); mx = fmaxf(fmaxf(mx, s1[2]), s1[3]); mx = fmaxf(fmaxf(mx, s1[4]), s1[5]); mx = fmaxf(fmaxf(mx, s1[6]), s1[7]);
    asm volatile("" : "+v"(kf[3]), "+v"(mx));
    ATT_MF(3);
    { const LAS unsigned char* kn2 = kn + 4096; asm volatile("" : "+v"(kn2), "+v"(mx));
#pragma unroll
      for (int d0 = 0; d0 < 2; ++d0) { kf[4 + 2 * d0] = *(const LAS f16x8*)(kn2 + d0 * 2048); kf[4 + 2 * d0 + 1] = *(const LAS f16x8*)(kn2 + d0 * 2048 + 512); } }
    ATT_MSK1(8); ATT_MSK1(9); ATT_MSK1(10); ATT_MSK1(11); ATT_MSK1(12); ATT_MSK1(13); ATT_MSK1(14); ATT_MSK1(15);
    mx = fmaxf(fmaxf(mx, s1[8]), s1[9]); mx = fmaxf(fmaxf(mx, s1[10]), s1[11]); mx = fmaxf(fmaxf(mx, s1[12]), s1[13]); mx = fmaxf(fmaxf(mx, s1[14]), s1[15]);
    asm volatile("" : "+v"(kf[4]), "+v"(mx));
    ATT_MF(4);
    { const auto rr = __builtin_amdgcn_permlane32_swap(__float_as_uint(mx), __float_as_uint(mx), false, false); mx = fmaxf(__uint_as_float(rr[0]), __uint_as_float(rr[1])); }
    const bool up = mx > mrun + ATT_THR;
    float mnew = up ? mx : mrun;
    const float alpha = __builtin_amdgcn_exp2f(mrun - mnew);
    mrun = mnew;
    asm volatile("" : "+v"(kf[5]), "+v"(mnew));
    ATT_MF(5);
    asm volatile("" : "+v"(kf[6]));
    ATT_MF(6);
    asm volatile("" : "+v"(kf[7]));
    ATT_MF(7);
#undef ATT_MF
#undef ATT_MSK0
#undef ATT_MSK1
    float rs = 0.f;
#define ATT_EX(S, r) do { S[r] = __builtin_amdgcn_exp2f(S[r] - mnew); rs += S[r]; } while (0)
#pragma unroll
    for (int ks = 0; ks < 4; ++ks) {
        s16x4 l0, h0, l1, h1;
        {
            unsigned vaddr = (unsigned)(size_t)(vt + ks * 1024);
            asm volatile("" : "+v"(vaddr), "+v"(rs));
            asm volatile("ds_read_b64_tr_b16 %0, %1" : "=v"(l0) : "v"(vaddr) : "memory");
            asm volatile("ds_read_b64_tr_b16 %0, %1 offset:512" : "=v"(h0) : "v"(vaddr) : "memory");
            asm volatile("ds_read_b64_tr_b16 %0, %1 offset:4096" : "=v"(l1) : "v"(vaddr) : "memory");
            asm volatile("ds_read_b64_tr_b16 %0, %1 offset:4608" : "=v"(h1) : "v"(vaddr) : "memory");
        }
        if (ks == 0) { ATT_EX(s0, 0); ATT_EX(s0, 1); ATT_EX(s0, 2); ATT_EX(s0, 3); ATT_EX(s0, 4); ATT_EX(s0, 5); ATT_EX(s0, 6); ATT_EX(s0, 7); }
        if (ks == 1) { ATT_EX(s0, 8); ATT_EX(s0, 9); ATT_EX(s0, 10); ATT_EX(s0, 11); ATT_EX(s0, 12); ATT_EX(s0, 13); ATT_EX(s0, 14); ATT_EX(s0, 15); }
        if (ks == 2) { ATT_EX(s1, 0); ATT_EX(s1, 1); ATT_EX(s1, 2); ATT_EX(s1, 3); ATT_EX(s1, 4); ATT_EX(s1, 5); ATT_EX(s1, 6); ATT_EX(s1, 7); }
        if (ks == 3) { ATT_EX(s1, 8); ATT_EX(s1, 9); ATT_EX(s1, 10); ATT_EX(s1, 11); ATT_EX(s1, 12); ATT_EX(s1, 13); ATT_EX(s1, 14); ATT_EX(s1, 15); }
        asm volatile("s_waitcnt lgkmcnt(0)" : "+v"(rs) :: "memory"); __builtin_amdgcn_sched_barrier(0);
        {
            const f16x8 v0 = __builtin_bit_cast(f16x8, (s16x8){l0[0], l0[1], l0[2], l0[3], h0[0], h0[1], h0[2], h0[3]}), v1 = __builtin_bit_cast(f16x8, (s16x8){l1[0], l1[1], l1[2], l1[3], h1[0], h1[1], h1[2], h1[3]});
            o0 = __builtin_amdgcn_mfma_f32_32x32x16_f16(pk[ks], v0, o0, 0, 0, 0);
            o1 = __builtin_amdgcn_mfma_f32_32x32x16_f16(pk[ks], v1, o1, 0, 0, 0);
            asm volatile("" : "+v"(mnew));
        }
#pragma unroll
        for (int j = 0; j < 8; ++j) pk[ks][j] = (h16)((ks < 2) ? s0[8 * (ks & 1) + j] : s1[8 * (ks & 1) + j]);
    }
#undef ATT_EX
    if (__any(up)) {
        if (hi == 0) wsf[r32] = alpha;
#pragma unroll
        for (int k = 0; k < 4; ++k) { const f32x4 al = *(const LAS f32x4*)(wsf + 8 * k + 4 * hi);
#pragma unroll
            for (int j = 0; j < 4; ++j) { o0[4 * k + j] *= al[j]; o1[4 * k + j] *= al[j]; } }
    }
    lrun = lrun * alpha + rs;
}

__device__ __forceinline__ void attn_phase(const Args& a, LAS unsigned char* lds, int G, int bid) {
    int tid = threadIdx.x; asm volatile("" : "+v"(tid));
    const int lane = tid & 63, wid = __builtin_amdgcn_readfirstlane(tid >> 6), r32 = lane & 31, hi = lane >> 5;
    const h16* Q = (const h16*)(a.ws + WS_Q); const h16* KB = (const h16*)(a.ws + WS_KB); const h16* VB = (const h16*)(a.ws + WS_VB);
    const h16* ZS = (const h16*)(a.ws + WS_ZS); h16* AO = (h16*)(a.ws + WS_AO);
    const unsigned long long* MASK = (const unsigned long long*)(a.ws + WS_MASK);
    LAS float* wsf = (LAS float*)(lds + ATT_W) + wid * 64;
    if (bid >= 256) return;
    const int bg = bid >> 3, s = bid & 7, b = bg >> 2, g = bg & 3;
    const int hh = g * 4 + (wid >> 1), qbase = 32 * (wid & 1);
#define ATT_WAITBAR(NA, NB) do { if (wid < 2) asm volatile("s_waitcnt vmcnt(" #NA ") lgkmcnt(0)\n\ts_barrier" ::: "memory"); else asm volatile("s_waitcnt vmcnt(" #NB ") lgkmcnt(0)\n\ts_barrier" ::: "memory"); } while (0)
#define ATT_CHUNK(U) ((((U) & 1) ? 16 * ((U) >> 1) + 15 - s : 16 * ((U) >> 1) + s))
    const h16* ksrc = KB + ((size_t)b * SEQ + lane) * 256 + g * 64 + wid * 8;
    const h16* vsrc = VB + ((size_t)b * SEQ + 16 * (wid & 3) + (lane >> 2)) * 256 + g * 64 + (wid >> 2) * 32 + (lane & 3) * 8;
    const unsigned* msrc0 = (const unsigned*)(MASK + ((size_t)(b * 64) * 64) * 64) + wid * 64 + lane;
    const LAS unsigned char* kb = lds + ATT_K + hi * 1024 + r32 * 16;
    const LAS unsigned char* vp = lds + ATT_V + ((lane >> 4) & 1) * 32 + (lane & 3) * 8 + (4 * hi + ((lane & 15) >> 2)) * 64;
    const LAS unsigned char* mp = lds + ATT_M + (qbase + r32) * 8;
    const unsigned dmaoff = (unsigned)wid * 1024u;
    int iu = 0, it = 0, ic = ATT_CHUNK(0), ik = 0, iv = 0, im = 0;
#define ATT_ISSUE() do { const int t_ = (iu < 8) ? it : 0;                                    \
        __builtin_amdgcn_global_load_lds((const unsigned*)(ksrc + (size_t)t_ * 64 * 256), (LAS unsigned*)(lds + ATT_K + ik * 8192 + dmaoff), 16, 0, 0); \
        __builtin_amdgcn_global_load_lds((const unsigned*)(vsrc + (size_t)t_ * 64 * 256), (LAS unsigned*)(lds + ATT_V + iv * 8192 + dmaoff), 16, 0, 0); \
        if (wid < 2) __builtin_amdgcn_global_load_lds(msrc0 + (size_t)ic * 8192 + (size_t)t_ * 128, (LAS unsigned*)(lds + ATT_M + im * 512 + wid * 256), 4, 0, 0); \
        ik = (ik == 2) ? 0 : ik + 1; iv = (iv == 4) ? 0 : iv + 1; im = (im + 1) & 7; \
        if (iu < 8) { ++it; if (it > ic) { ++iu; it = 0; ic = ATT_CHUNK(iu < 8 ? iu : 7); } } } while (0)
#define ATT_QDMA(U) do { const size_t tq_ = (size_t)b * SEQ + ATT_CHUNK(U) * 64 + qbase + r32; \
        _Pragma("unroll") for (int d0 = 0; d0 < 4; ++d0) \
            __builtin_amdgcn_global_load_lds((const unsigned*)(Q + tq_ * 1024 + hh * 64 + d0 * 16 + hi * 8), (LAS unsigned*)(lds + ATT_Q + ((U) & 1) * 32768 + wid * 4096 + d0 * 1024), 16, 0, 0); } while (0)
    { f16x8 zero8 = (f16x8){}; asm volatile("" : "+v"(zero8)); *(LAS f16x8*)(lds + ATT_V + 4 * 8192 + wid * 1024 + lane * 16) = zero8; }
    ATT_QDMA(0);
    ATT_ISSUE(); ATT_ISSUE(); ATT_ISSUE();
    ATT_WAITBAR(5, 3);
    int ck = 0, cv = 0, cm = 0;
    for (int ui = 0; ui < 8; ++ui) {
        const int c = ATT_CHUNK(ui), nT = c + 1;
        const size_t tok0 = (size_t)b * SEQ + c * 64;
        const LAS unsigned char* qp = lds + ATT_Q + (ui & 1) * 32768 + wid * 4096 + lane * 16;
        f32x16 o0 = {}, o1 = {};
        float mrun = -1e30f, lrun = 0.f;
        f32x16 sa0 = {}, sa1 = {}, sb0 = {}, sb1 = {};
        {
            const LAS unsigned char* k0p = kb + ck * 8192;
#pragma unroll
            for (int d0 = 0; d0 < 4; ++d0) {
                const f16x8 k0 = *(const LAS f16x8*)(k0p + d0 * 2048), k1 = *(const LAS f16x8*)(k0p + d0 * 2048 + 512), qf = *(const LAS f16x8*)(qp + d0 * 1024);
                sa0 = __builtin_amdgcn_mfma_f32_32x32x16_f16(k0, qf, sa0, 0, 0, 0);
                sa1 = __builtin_amdgcn_mfma_f32_32x32x16_f16(k1, qf, sa1, 0, 0, 0);
            }
        }
        f16x8 pk[4];
#pragma unroll
        for (int k = 0; k < 4; ++k) pk[k] = (f16x8){};
        asm volatile("s_waitcnt lgkmcnt(0)\n\ts_barrier" ::: "memory");
#define ATT_STEP(SC0, SC1, SN0, SN1, T) do { const int t_ = (T); const bool lastt = (t_ == nT - 1) && (ui < 7); \
            if (lastt) ATT_QDMA(ui + 1); \
            ATT_ISSUE(); \
            const unsigned long long mw_ = *(const LAS unsigned long long*)(mp + cm * 512); \
            att_tile(SC0, SC1, SN0, SN1, pk, o0, o1, lrun, mrun, qp, kb + ((ck == 2) ? 0 : ck + 1) * 8192, vp + ((cv == 0) ? 4 : cv - 1) * 8192, mw_, wsf, hi, r32); \
            if (lastt) ATT_WAITBAR(9, 7); else ATT_WAITBAR(5, 3); \
            ck = (ck == 2) ? 0 : ck + 1; cv = (cv == 4) ? 0 : cv + 1; cm = (cm + 1) & 7; } while (0)
        int t = 0;
        for (; t + 1 < nT; t += 2) { ATT_STEP(sa0, sa1, sb0, sb1, t); ATT_STEP(sb0, sb1, sa0, sa1, t + 1); }
        if (t < nT) ATT_STEP(sa0, sa1, sb0, sb1, t);
#undef ATT_STEP
        {
            typedef short s16x8 __attribute__((ext_vector_type(8))); typedef short s16x4 __attribute__((ext_vector_type(4)));
            const unsigned vaddr0 = (unsigned)(size_t)(vp + ((cv == 0) ? 4 : cv - 1) * 8192);
#pragma unroll
            for (int ks = 0; ks < 4; ++ks) {
                s16x4 l0, h0, l1, h1; unsigned vaddr = vaddr0 + ks * 1024;
                asm volatile("ds_read_b64_tr_b16 %0, %1" : "=v"(l0) : "v"(vaddr) : "memory");
                asm volatile("ds_read_b64_tr_b16 %0, %1 offset:512" : "=v"(h0) : "v"(vaddr) : "memory");
                asm volatile("ds_read_b64_tr_b16 %0, %1 offset:4096" : "=v"(l1) : "v"(vaddr) : "memory");
                asm volatile("ds_read_b64_tr_b16 %0, %1 offset:4608" : "=v"(h1) : "v"(vaddr) : "memory");
                asm volatile("s_waitcnt lgkmcnt(0)" ::: "memory"); __builtin_amdgcn_sched_barrier(0);
                const f16x8 v0 = __builtin_bit_cast(f16x8, (s16x8){l0[0], l0[1], l0[2], l0[3], h0[0], h0[1], h0[2], h0[3]}), v1 = __builtin_bit_cast(f16x8, (s16x8){l1[0], l1[1], l1[2], l1[3], h1[0], h1[1], h1[2], h1[3]});
                o0 = __builtin_amdgcn_mfma_f32_32x32x16_f16(pk[ks], v0, o0, 0, 0, 0);
                o1 = __builtin_amdgcn_mfma_f32_32x32x16_f16(pk[ks], v1, o1, 0, 0, 0);
            }
        }
        lrun += __shfl_xor(lrun, 32);
        if (hi == 0) wsf[r32] = __builtin_amdgcn_rcpf(lrun);
        LAS h16* stg = (LAS h16*)(lds + ATT_Q + (ui & 1) * 32768 + wid * 4096);
#pragma unroll
        for (int r = 0; r < 16; ++r) {
            const int q = crow(r, hi); const float li = wsf[q];
            stg[q * 64 + r32] = (h16)(o0[r] * li); stg[q * 64 + 32 + r32] = (h16)(o1[r] * li);
        }
        const size_t orow0 = tok0 + qbase;
#pragma unroll
        for (int i = 0; i < 4; ++i) {
            const int row = i * 8 + (lane >> 3), ch = lane & 7;
            const f16x8 ov = *(const LAS f16x8*)(stg + row * 64 + ch * 8);
            const size_t off = (orow0 + row) * 1024 + hh * 64 + ch * 8;
            const f16x8 zv = *(const f16x8*)(ZS + off);
            f16x8 res;
#pragma unroll
            for (int jj = 0; jj < 8; ++jj) res[jj] = (h16)((float)ov[jj] * (float)zv[jj]);
            *(f16x8*)(AO + off) = res;
        }
    }
    asm volatile("s_waitcnt vmcnt(0)" ::: "memory");
    __syncthreads();
#undef ATT_WAITBAR
#undef ATT_CHUNK
#undef ATT_ISSUE
#undef ATT_QDMA
}

__device__ __forceinline__ void final_phase(const Args& a, int G, int bid) {
    int tid = threadIdx.x; asm volatile("" : "+v"(tid));
    const int lane = tid & 63, wave = tid >> 6;
    const float* rss = (const float*)(a.ws + WS_RSS2);
    for (int row = bid * 8 + wave; row < MTOK; row += G * 8) {
        const float rs = __builtin_amdgcn_rsqf(rss[row] * (1.0f / 1024.0f) + NORM_EPS);
        f32x4* p = (f32x4*)(a.out + (size_t)row * 1024) + lane;
#pragma unroll
        for (int j = 0; j < 4; ++j) { const f32x4 g = *((const f32x4*)a.final_g + lane + 64 * j); p[64 * j] = p[64 * j] * rs * g; }
    }
}

#define XB_TMO      128
#define XB_XCNT(j)  (256  + 64 * (j))
#define XB_XSUB(j)  (1280 + 64 * (j))
#define XB_XGEN(j)  (2304 + 64 * (j))
#define XB_TOP      3328
#define XB_TOPGEN   3392
#define XCD_BAR_WORDS 3456
#define XB_SPIN_CAP (1u << 18)
__device__ __forceinline__ unsigned xb_ld(unsigned* p)              { return __hip_atomic_load(p, __ATOMIC_RELAXED, __HIP_MEMORY_SCOPE_AGENT); }
__device__ __forceinline__ unsigned xb_add(unsigned* p, unsigned v) { return __hip_atomic_fetch_add(p, v, __ATOMIC_RELAXED, __HIP_MEMORY_SCOPE_AGENT); }
__device__ __forceinline__ unsigned xb_xcc_id() { return (unsigned)__builtin_amdgcn_s_getreg((3 << 11) | 20) & 0xFu; }
#define XB_SPIN(cond, bar) do { unsigned _sp = 0; while (cond) { __builtin_amdgcn_s_sleep(1); \
    if ((++_sp & 255u) == 0u) { if (xb_ld(&(bar)[XB_TMO])) break; if (_sp > XB_SPIN_CAP) { atomicAdd(&(bar)[XB_TMO], 1u); break; } } } } while (0)
struct XcdBarrier { unsigned* bar; unsigned x; volatile LAS unsigned* st; };
__device__ __forceinline__ XcdBarrier xcd_barrier_post(unsigned* bar, volatile LAS unsigned* st) {
    XcdBarrier b; b.bar = bar; b.x = xb_xcc_id(); b.st = st;
    if (threadIdx.x == 0) (void)xb_add(&bar[XB_XCNT(b.x)], 1u);
    return b;
}
__device__ __forceinline__ void xcd_barrier_complete(unsigned* bar, unsigned x, unsigned& nloc, unsigned& nx) {
    const unsigned G = gridDim.x * gridDim.y * gridDim.z;
    unsigned sum, cnt, mine, sp = 0u;
    for (;;) {
        sum = 0u; cnt = 0u; mine = 0u;
#pragma unroll
        for (unsigned j = 0; j < 16; ++j) { const unsigned c = xb_ld(&bar[XB_XCNT(j)]); sum += c; cnt += (c > 0u) ? 1u : 0u; mine = (j == x) ? c : mine; }
        if (sum == G) break;
        __builtin_amdgcn_s_sleep(1);
        if ((++sp & 255u) == 0u) { if (xb_ld(&bar[XB_TMO])) break; if (sp > XB_SPIN_CAP) { atomicAdd(&bar[XB_TMO], 1u); break; } }
    }
    nloc = mine > 0u ? mine : 1u; nx = cnt > 0u ? cnt : 1u;
}
__device__ __forceinline__ void xcd_barrier(const XcdBarrier& b) {
    asm volatile("s_waitcnt vmcnt(0)" ::: "memory");
    __syncthreads();
    if (threadIdx.x == 0) {
        unsigned* bar = b.bar;
        __builtin_amdgcn_s_waitcnt(0);
        unsigned nloc = b.st[0], nx = b.st[1];
        if (nloc == 0u) { xcd_barrier_complete(bar, b.x, nloc, nx); b.st[0] = nloc; b.st[1] = nx; }
        const unsigned old = xb_add(&bar[XB_XSUB(b.x)], 1u);
        const unsigned gen = old / nloc;
        if (old + 1u == (gen + 1u) * nloc) {
            __builtin_amdgcn_fence(__ATOMIC_RELEASE, "agent");
            asm volatile("s_waitcnt vmcnt(0)" ::: "memory");
            const unsigned og = xb_add(&bar[XB_TOP], 1u);
            const unsigned tg = og / nx;
            if (og + 1u == (tg + 1u) * nx) xb_add(&bar[XB_TOPGEN], 1u);
            else XB_SPIN(xb_ld(&bar[XB_TOPGEN]) == tg, bar);
            __builtin_amdgcn_fence(__ATOMIC_ACQUIRE, "agent");
            xb_add(&bar[XB_XGEN(b.x)], 1u);
            asm volatile("s_waitcnt vmcnt(0)" ::: "memory");
        } else {
            XB_SPIN(xb_ld(&bar[XB_XGEN(b.x)]) == gen, bar);
            __builtin_amdgcn_fence(__ATOMIC_ACQUIRE, "agent");
            asm volatile("s_waitcnt vmcnt(0)" ::: "memory");
        }
    }
    __syncthreads();
}

__global__ void __launch_bounds__(NTHREADS, 2) mega(Args a) {
    extern __shared__ __attribute__((aligned(16))) unsigned char lds_raw[];
    LAS unsigned char* lds = (LAS unsigned char*)lds_raw;
    const int G = gridDim.x, bid = blockIdx.x;
    unsigned char* ws = a.ws;
#if ONE_LAUNCH
    volatile LAS unsigned* bst = (volatile LAS unsigned*)(lds + LDS_BYTES - 64);
    if (threadIdx.x < 2) bst[threadIdx.x] = 0u;
    __syncthreads();
    const XcdBarrier xbar = xcd_barrier_post((unsigned*)(ws + WS_BAR), bst);
#define SEAM() xcd_barrier(xbar)
#else
#define SEAM() do {} while (0)
#endif
    for (int ph = a.ph_lo; ph < a.ph_hi; ++ph) {
      for (int rep = 0; rep < (((PH_REP >> ph) & 1) ? 2 : 1); ++rep) {
        if (rep) { SEAM(); }
        GemmP g{nullptr, nullptr, 1024, 1024, 1024, 0, 0, MTOK / 256, 4, 0}; int mode = -1;
        if (ph == 1) { g.A = (const char*)(ws + WS_XN); g.Bt = (const char*)(ws + WS_WE_IN); g.nN = NE_IN / 256; mode = E_EVEN_IN; }
        else if (ph == 2) { g = GemmP{(const char*)(ws + WS_UA), (const char*)(ws + WS_MS), 384, 256, 256, 2048L * 384 * 2, 256L * 256 * 2, 8, 1, 32}; mode = E_SEND; }
        else if (ph == 4) { g = GemmP{(const char*)(ws + WS_UA), (const char*)(ws + WS_MY), 384, 384, 384, 2048L * 384 * 2, 256L * 384 * 2, 8, 1, 32}; mode = E_Y; }
        else if (ph == 5) { g = GemmP{(const char*)(ws + WS_GG), (const char*)(ws + WS_WGLU), 512, 512, 512, 0, 0, MTOK / 256, 2, 0}; mode = E_GLU; }
        else if (ph == 6) { g.A = (const char*)(ws + WS_YCAT); g.Bt = (const char*)(ws + WS_WE_OUT); mode = E_OUT_EVEN; }
        else if (ph == 7) { g.A = (const char*)(ws + WS_XN); g.Bt = (const char*)(ws + WS_WO_IN); g.nN = NO_PAD / 256; mode = E_ODD_IN; }
        else if (ph == 10) { g.A = (const char*)(ws + WS_AO); g.Bt = (const char*)(ws + WS_WO_OUT); mode = E_OUT_ODD; }
#ifdef FIXED_MODE
        if (mode >= 0 && ((PH_EN >> ph) & 1)) gemm_phase(lds, g, FIXED_MODE, a, G, bid);
#else
        if (mode >= 0 && ((PH_EN >> ph) & 1)) gemm_phase(lds, g, mode, a, G, bid);
#endif
        if (ph == 0 && (PH_EN & 1)) p0_prologue(a, lds, G, bid);
        else if (ph == 1 && (PH_EN & 2)) s5_fill(a, G, bid);
        else if (ph == 2 && (PH_EN & 4)) { asm volatile("s_waitcnt vmcnt(0)" ::: "memory"); __syncthreads(); scan_phase(a, lds, G, bid); __syncthreads(); conv_phase(a, lds, G, bid); }
        else if (ph == 8 && (PH_EN & 0x100)) idx_phase(a, lds, G, bid);
        else if (ph == 9 && (PH_EN & 0x200)) attn_phase(a, lds, G, bid);

      }
        if (ph + 1 < a.ph_hi && ph != 3 && ph < 10) { SEAM(); }
#ifdef XSYNC
        if (ph == 5) { for (int xs = 0; xs < XSYNC; ++xs) { SEAM(); } }
#endif
    }
}

extern "C" void kernel_launch(void* const* d_in, const int* in_sizes, int n_in, void* d_out, int out_size, void* d_ws, size_t ws_size, hipStream_t stream) {
    static int grid = 0;
    if (grid == 0) {
        if (n_in != 21 || out_size != MTOK * DM || ws_size < WS_END) { fprintf(stderr, "kernel_launch: unexpected problem (n_in %d, out %d, ws %zu)\n", n_in, out_size, ws_size); grid = -1; return; }
        if (hipFuncSetAttribute((const void*)mega, hipFuncAttributeMaxDynamicSharedMemorySize, LDS_BYTES) != hipSuccess) { fprintf(stderr, "kernel_launch: hipFuncSetAttribute failed\n"); grid = -1; return; }
        int dev = 0, cus = 0, per_cu = 0;
        (void)hipGetDevice(&dev); (void)hipDeviceGetAttribute(&cus, hipDeviceAttributeMultiprocessorCount, dev);
        (void)hipOccupancyMaxActiveBlocksPerMultiprocessor(&per_cu, (const void*)mega, NTHREADS, LDS_BYTES);
        if (per_cu < 1 || cus != 256) { fprintf(stderr, "kernel_launch: occupancy %d blocks/CU, %d CUs: this kernel needs 1 block on each of 256 CUs\n", per_cu, cus); grid = -1; return; }
        grid = 256;
    }
    if (grid < 0) return;
    (void)hipMemsetAsync((char*)d_ws, 0, CTL_ZERO_BYTES, stream);
    Args a{};
    const float** ap = (const float**)&a;
    for (int i = 0; i < 21; ++i) ap[i] = (const float*)d_in[i];
    a.out = (float*)d_out; a.ws = (unsigned char*)d_ws;
#if ONE_LAUNCH
    a.ph_lo = 0; a.ph_hi = NPHASE;
    void* args[] = {&a};
    hipError_t e = hipLaunchCooperativeKernel((const void*)mega, dim3(grid), dim3(NTHREADS), args, LDS_BYTES, stream);
    if (e != hipSuccess) fprintf(stderr, "cooperative launch failed: %s\n", hipGetErrorString(e));
#else
    for (int ph = 0; ph < NPHASE; ++ph) { a.ph_lo = ph; a.ph_hi = ph + 1; hipLaunchKernelGGL(mega, dim3(grid), dim3(NTHREADS), LDS_BYTES, stream, a); }
#endif
}
```
